# Optimizing an MI355X kernel written in HIP

```python
import math
import jax, jax.numpy as jnp
from jax import lax
import numpy as np

D_MODEL = 1024
BATCH = 2
SEQ = 8192
DEPTH = 1
DEC_BATCH = 128
DEC_SEQ = 8
PAST_LEN = 8192
PAGE_SIZE = 128

D_PLE = 256
D_FF = 2816
SSM_GROUP = 16
SSM_STATE = 64
D_SSM = 512
N_SSM_GROUPS = D_SSM // SSM_GROUP
HEAD_DIM = 64
HEADS_PER_GROUP = 4
WINDOWS = (128, 512, 2048)
DILATIONS = (1, 4, 16)
N_ATTN_GROUPS = 3
D_ATTN_GROUP = HEADS_PER_GROUP * HEAD_DIM
D_ATTN = N_ATTN_GROUPS * D_ATTN_GROUP
N_STEPS = WINDOWS[0] // DILATIONS[0]
Q_BLOCK = 128
D_IN = D_SSM + 3 * D_ATTN + 2 * D_MODEL
ATTN_SCALE = HEAD_DIM ** -0.5
EPS = 1e-6

kernel_name = 'hybrid_s5_dilated_attn_decoder_step'


def _rmsnorm(x, g):
    xf = x.astype(jnp.float32)
    y = xf * lax.rsqrt(jnp.mean(xf * xf, axis=-1, keepdims=True) + EPS) * g.astype(jnp.float32)
    return y.astype(x.dtype)


def _swiglu(h, w_gate, w_up, w_down):
    return (jax.nn.silu(h @ w_gate) * (h @ w_up)) @ w_down


def _cplx_affine_combine(e1, e2):
    a1r, a1i, b1r, b1i = e1
    a2r, a2i, b2r, b2i = e2
    return (a2r * a1r - a2i * a1i, a2r * a1i + a2i * a1r,
            a2r * b1r - a2i * b1i + b2r, a2r * b1i + a2i * b1r + b2i)


def _ssm_branch(u, h0, a_re, a_im, log_dt, b_re, b_im, c_re, c_im, d_skip, w_glu):
    f32 = jnp.float32
    n, l, _ = u.shape
    a_re, a_im = a_re.astype(f32), a_im.astype(f32)
    dt = jnp.exp(log_dt.astype(f32))[:, None]
    mag = jnp.exp(a_re * dt)
    ab_re, ab_im = mag * jnp.cos(a_im * dt), mag * jnp.sin(a_im * dt)
    den = a_re * a_re + a_im * a_im
    nr, ni = ab_re - 1.0, ab_im
    f_re = (nr * a_re + ni * a_im) / den
    f_im = (ni * a_re - nr * a_im) / den
    br, bi = b_re.astype(f32), b_im.astype(f32)
    bb_re = f_re[..., None] * br - f_im[..., None] * bi
    bb_im = f_re[..., None] * bi + f_im[..., None] * br
    ug = u.astype(f32).reshape(n, l, N_SSM_GROUPS, SSM_GROUP)
    bu_re = jnp.einsum('nlgc,gpc->nlgp', ug, bb_re)
    bu_im = jnp.einsum('nlgc,gpc->nlgp', ug, bb_im)
    h0r, h0i = h0[..., 0].astype(f32), h0[..., 1].astype(f32)
    bu_re = bu_re.at[:, 0].add(ab_re * h0r - ab_im * h0i)
    bu_im = bu_im.at[:, 0].add(ab_re * h0i + ab_im * h0r)
    a_r = jnp.broadcast_to(ab_re, bu_re.shape)
    a_i = jnp.broadcast_to(ab_im, bu_im.shape)
    _, _, h_re, h_im = lax.associative_scan(_cplx_affine_combine, (a_r, a_i, bu_re, bu_im), axis=1)
    y = (jnp.einsum('nlgp,gcp->nlgc', h_re, c_re.astype(f32))
         - jnp.einsum('nlgp,gcp->nlgc', h_im, c_im.astype(f32))
         + d_skip.astype(f32).reshape(N_SSM_GROUPS, SSM_GROUP) * ug)
    y = jax.nn.gelu(y.reshape(n, l, D_SSM)).astype(u.dtype)
    out = y * jax.nn.sigmoid(y @ w_glu)
    h_last = jnp.stack([h_re[:, -1], h_im[:, -1]], axis=-1)
    return out, h_last


def _dilated_attn_prompt(q, k, v, dil):
    n, s, h, e = q.shape
    blk = dil * Q_BLOCK
    s_pad = -(-s // blk) * blk
    m_len = s_pad // dil
    nb = m_len // Q_BLOCK

    def to_res(a):
        a = jnp.pad(a, ((0, 0), (0, s_pad - s), (0, 0), (0, 0)))
        return a.reshape(n, m_len, dil, h, e).transpose(0, 2, 1, 3, 4)

    def band(a):
        ap = jnp.pad(a, ((0, 0), (0, 0), (Q_BLOCK, 0), (0, 0), (0, 0)))
        prev = ap[:, :, :m_len].reshape(n, dil, nb, Q_BLOCK, h, e)
        cur = a.reshape(n, dil, nb, Q_BLOCK, h, e)
        return jnp.concatenate([prev, cur], axis=3)

    qb = to_res(q).reshape(n, dil, nb, Q_BLOCK, h, e)
    kb, vb = band(to_res(k)), band(to_res(v))
    sc = jnp.einsum('ndbqhe,ndbkhe->ndbhqk', qb, kb).astype(jnp.float32) * ATTN_SCALE
    qi = jnp.arange(Q_BLOCK)[:, None]
    ki = jnp.arange(2 * Q_BLOCK)[None, :]
    diff = Q_BLOCK + qi - ki
    key_m = jnp.arange(nb)[:, None, None] * Q_BLOCK - Q_BLOCK + ki
    valid = (diff >= 0) & (diff <= N_STEPS) & (key_m >= 0)
    sc = jnp.where(valid[:, None], sc, -jnp.inf)
    mx = jnp.max(sc, axis=-1, keepdims=True)
    pe = jnp.exp(sc - mx)
    den = jnp.sum(pe, axis=-1, keepdims=True)
    o = jnp.einsum('ndbhqk,ndbkhe->ndbqhe', (pe / den).astype(v.dtype), vb)
    lse = (mx + jnp.log(den))[..., 0]
    o = o.reshape(n, dil, m_len, h, e).transpose(0, 2, 1, 3, 4).reshape(n, s_pad, h, e)[:, :s]
    lse = lse.transpose(0, 2, 4, 1, 3).reshape(n, s_pad, h)[:, :s]
    return o, lse


def _dilated_attn_sample(q, k, v, buf, dil):
    n, l, h, e = q.shape
    wb = buf.shape[1]
    k_all = jnp.concatenate([buf[:, :, 0].astype(k.dtype), k], axis=1)
    v_all = jnp.concatenate([buf[:, :, 1].astype(v.dtype), v], axis=1)
    idx = wb + jnp.arange(l)[:, None] - dil * jnp.arange(N_STEPS + 1)[None, :]
    valid = idx >= 0
    idx = jnp.maximum(idx, 0)
    kg, vg = k_all[:, idx], v_all[:, idx]
    sc = jnp.einsum('nlhe,nlkhe->nlhk', q, kg).astype(jnp.float32) * ATTN_SCALE
    sc = jnp.where(valid[:, None, :], sc, -jnp.inf)
    mx = jnp.max(sc, axis=-1, keepdims=True)
    pe = jnp.exp(sc - mx)
    den = jnp.sum(pe, axis=-1, keepdims=True)
    o = jnp.einsum('nlhk,nlkhe->nlhe', (pe / den).astype(v.dtype), vg)
    return o, (mx + jnp.log(den))[..., 0]


def _layer(x, p, h0, bufs, lw):
    n, l, _ = x.shape
    x = x + 0.5 * _swiglu(_rmsnorm(x, lw['g_ffn1']), lw['ffn1_w_gate'], lw['ffn1_w_up'], lw['ffn1_w_down'])
    h = _rmsnorm(x, lw['g_mix'])
    z = h @ lw['w_in']
    u = z[..., :D_SSM]
    qkv = z[..., D_SSM:D_SSM + 3 * D_ATTN].reshape(n, l, 3, N_ATTN_GROUPS, HEADS_PER_GROUP, HEAD_DIM)
    gate_a = z[..., D_SSM + 3 * D_ATTN:D_SSM + 3 * D_ATTN + D_MODEL]
    gate_b = z[..., D_SSM + 3 * D_ATTN + D_MODEL:]
    y_ssm, h_new = _ssm_branch(u, h0, lw['ssm_a_re'], lw['ssm_a_im'], lw['ssm_log_dt'], lw['ssm_b_re'],
                               lw['ssm_b_im'], lw['ssm_c_re'], lw['ssm_c_im'], lw['ssm_d'], lw['ssm_w_glu'])
    outs, lses, kv_new = [], [], []
    for g in range(N_ATTN_GROUPS):
        qg, kg, vg = qkv[:, :, 0, g], qkv[:, :, 1, g], qkv[:, :, 2, g]
        if bufs is None:
            o, lse = _dilated_attn_prompt(qg, kg, vg, DILATIONS[g])
            keep = min(WINDOWS[g], l)
            kv_new.append(jnp.stack([kg[:, l - keep:], vg[:, l - keep:]], axis=2))
        else:
            o, lse = _dilated_attn_sample(qg, kg, vg, bufs[g], DILATIONS[g])
            kv_new.append(jnp.stack([kg, vg], axis=2))
        outs.append(o)
        lses.append(lse)
    w_grp = jax.nn.softmax(jnp.stack(lses, axis=0), axis=0)
    y_attn = jnp.einsum('gnlh,gnlhe->nlhe', w_grp.astype(x.dtype), jnp.stack(outs, axis=0)).reshape(n, l, D_ATTN_GROUP)
    merged = (jax.nn.sigmoid(gate_a) * (y_ssm @ lw['w_br_ssm'])
              + jax.nn.sigmoid(gate_b) * (y_attn @ lw['w_br_attn']))
    x = x + merged @ lw['w_out']
    x = x + 0.5 * _swiglu(_rmsnorm(x, lw['g_ffn2']), lw['ffn2_w_gate'], lw['ffn2_w_up'], lw['ffn2_w_down'])
    x = x + jax.nn.sigmoid(_rmsnorm(x, lw['g_ple']) @ lw['w_ple_gate']) * (p @ lw['w_ple_proj'])
    return x, kv_new, h_new


def setup_inputs(seed: int = 0) -> dict:
    key = jax.random.key(seed)
    ks = list(jax.random.split(key, 40))
    f32 = jnp.float32

    def nrm(k, shape, scale):
        return jax.random.normal(k, shape, f32) * scale

    def gain(k, shape):
        return 1.0 + 0.01 * jax.random.normal(k, shape, f32)

    G, P = N_SSM_GROUPS, SSM_STATE
    kv_shape = lambda w: (DEPTH, DEC_BATCH, min(w, PAST_LEN), 2, HEADS_PER_GROUP, HEAD_DIM)
    a_im0 = math.pi * jnp.arange(P, dtype=f32)
    return {
        'x_prompt': nrm(ks[0], (BATCH, SEQ, D_MODEL), 1.0),
        'x_sample': nrm(ks[1], (DEC_BATCH, DEC_SEQ, D_MODEL), 1.0),
        'p_prompt': nrm(ks[2], (DEPTH, BATCH, SEQ, D_PLE), 1.0),
        'p_sample': nrm(ks[3], (DEPTH, DEC_BATCH, DEC_SEQ, D_PLE), 1.0),
        'cache_kv_w128': nrm(ks[4], kv_shape(WINDOWS[0]), 1.0),
        'cache_kv_w512': nrm(ks[5], kv_shape(WINDOWS[1]), 1.0),
        'cache_kv_w2048': nrm(ks[6], kv_shape(WINDOWS[2]), 1.0),
        'state_ssm': nrm(ks[7], (DEPTH, DEC_BATCH, G, P, 2), 0.1),
        'g_ffn1': gain(ks[8], (DEPTH, D_MODEL)),
        'ffn1_w_gate': nrm(ks[9], (DEPTH, D_MODEL, D_FF), D_MODEL ** -0.5),
        'ffn1_w_up': nrm(ks[10], (DEPTH, D_MODEL, D_FF), D_MODEL ** -0.5),
        'ffn1_w_down': nrm(ks[11], (DEPTH, D_FF, D_MODEL), D_FF ** -0.5),
        'g_mix': gain(ks[12], (DEPTH, D_MODEL)),
        'w_in': nrm(ks[13], (DEPTH, D_MODEL, D_IN), D_MODEL ** -0.5),
        'ssm_a_re': -0.5 + 0.01 * jax.random.normal(ks[14], (DEPTH, G, P), f32),
        'ssm_a_im': a_im0 + 0.01 * jax.random.normal(ks[15], (DEPTH, G, P), f32),
        'ssm_log_dt': jax.random.uniform(ks[16], (DEPTH, G), f32, math.log(1e-3), math.log(1e-1)),
        'ssm_b_re': nrm(ks[17], (DEPTH, G, P, SSM_GROUP), (2 * SSM_GROUP) ** -0.5),
        'ssm_b_im': nrm(ks[18], (DEPTH, G, P, SSM_GROUP), (2 * SSM_GROUP) ** -0.5),
        'ssm_c_re': nrm(ks[19], (DEPTH, G, SSM_GROUP, P), P ** -0.5),
        'ssm_c_im': nrm(ks[20], (DEPTH, G, SSM_GROUP, P), P ** -0.5),
        'ssm_d': nrm(ks[21], (DEPTH, D_SSM), 1.0),
        'ssm_w_glu': nrm(ks[22], (DEPTH, D_SSM, D_SSM), D_SSM ** -0.5),
        'w_br_ssm': nrm(ks[23], (DEPTH, D_SSM, D_MODEL), D_SSM ** -0.5),
        'w_br_attn': nrm(ks[24], (DEPTH, D_ATTN_GROUP, D_MODEL), D_ATTN_GROUP ** -0.5),
        'w_out': nrm(ks[25], (DEPTH, D_MODEL, D_MODEL), D_MODEL ** -0.5),
        'g_ffn2': gain(ks[26], (DEPTH, D_MODEL)),
        'ffn2_w_gate': nrm(ks[27], (DEPTH, D_MODEL, D_FF), D_MODEL ** -0.5),
        'ffn2_w_up': nrm(ks[28], (DEPTH, D_MODEL, D_FF), D_MODEL ** -0.5),
        'ffn2_w_down': nrm(ks[29], (DEPTH, D_FF, D_MODEL), D_FF ** -0.5),
        'g_ple': gain(ks[30], (DEPTH, D_MODEL)),
        'w_ple_gate': nrm(ks[31], (DEPTH, D_MODEL, D_MODEL), D_MODEL ** -0.5),
        'w_ple_proj': nrm(ks[32], (DEPTH, D_PLE, D_MODEL), D_PLE ** -0.5),
        'g_final': gain(ks[33], (D_MODEL,)),
    }


def reference(x_prompt, x_sample, p_prompt, p_sample, cache_kv_w128, cache_kv_w512, cache_kv_w2048, state_ssm,
              g_ffn1, ffn1_w_gate, ffn1_w_up, ffn1_w_down, g_mix, w_in, ssm_a_re, ssm_a_im, ssm_log_dt,
              ssm_b_re, ssm_b_im, ssm_c_re, ssm_c_im, ssm_d, ssm_w_glu, w_br_ssm, w_br_attn, w_out,
              g_ffn2, ffn2_w_gate, ffn2_w_up, ffn2_w_down, g_ple, w_ple_gate, w_ple_proj, g_final):
    xp, xs = x_prompt, x_sample
    kvp = ([], [], [])
    kvs = ([], [], [])
    hp_all, hs_all = [], []
    for i in range(DEPTH):
        lw = {
            'g_ffn1': g_ffn1[i], 'ffn1_w_gate': ffn1_w_gate[i], 'ffn1_w_up': ffn1_w_up[i], 'ffn1_w_down': ffn1_w_down[i],
            'g_mix': g_mix[i], 'w_in': w_in[i],
            'ssm_a_re': ssm_a_re[i], 'ssm_a_im': ssm_a_im[i], 'ssm_log_dt': ssm_log_dt[i],
            'ssm_b_re': ssm_b_re[i], 'ssm_b_im': ssm_b_im[i], 'ssm_c_re': ssm_c_re[i], 'ssm_c_im': ssm_c_im[i],
            'ssm_d': ssm_d[i], 'ssm_w_glu': ssm_w_glu[i],
            'w_br_ssm': w_br_ssm[i], 'w_br_attn': w_br_attn[i], 'w_out': w_out[i],
            'g_ffn2': g_ffn2[i], 'ffn2_w_gate': ffn2_w_gate[i], 'ffn2_w_up': ffn2_w_up[i], 'ffn2_w_down': ffn2_w_down[i],
            'g_ple': g_ple[i], 'w_ple_gate': w_ple_gate[i], 'w_ple_proj': w_ple_proj[i],
        }
        h0p = jnp.zeros((xp.shape[0], N_SSM_GROUPS, SSM_STATE, 2), jnp.float32)
        xp, kv_p, hp = _layer(xp, p_prompt[i], h0p, None, lw)
        xs, kv_s, hs = _layer(xs, p_sample[i], state_ssm[i], (cache_kv_w128[i], cache_kv_w512[i], cache_kv_w2048[i]), lw)
        for g in range(N_ATTN_GROUPS):
            kvp[g].append(kv_p[g])
            kvs[g].append(kv_s[g])
        hp_all.append(hp)
        hs_all.append(hs)
    y_prompt = _rmsnorm(xp, g_final)
    y_sample = _rmsnorm(xs, g_final)
    kv_w128_prompt = jnp.stack(kvp[0], axis=0)
    kv_w512_prompt = jnp.stack(kvp[1], axis=0)
    kv_w2048_prompt = jnp.stack(kvp[2], axis=0)
    ssm_prompt = jnp.stack(hp_all, axis=0)
    kv_w128_sample = jnp.stack(kvs[0], axis=0)
    kv_w512_sample = jnp.stack(kvs[1], axis=0)
    kv_w2048_sample = jnp.stack(kvs[2], axis=0)
    ssm_sample = jnp.stack(hs_all, axis=0)
    return (y_prompt, y_sample, kv_w128_prompt, kv_w512_prompt, kv_w2048_prompt, ssm_prompt,
            kv_w128_sample, kv_w512_sample, kv_w2048_sample, ssm_sample)
```

```cpp
#include <hip/hip_runtime.h>
#include <cstdio>
#include <cstdint>

#ifndef MK_N_LAUNCHES
#define MK_N_LAUNCHES 1
#endif

#define LAS __attribute__((address_space(3)))
#define GAS __attribute__((address_space(1)))
typedef unsigned short bf16_t;
typedef short bf16x8 __attribute__((ext_vector_type(8)));
typedef short s16x4 __attribute__((ext_vector_type(4)));
typedef float f32x4 __attribute__((ext_vector_type(4)));
typedef float f32x2 __attribute__((ext_vector_type(2)));
typedef float f32x16 __attribute__((ext_vector_type(16)));
typedef unsigned u32x4 __attribute__((ext_vector_type(4)));
typedef unsigned u32x2 __attribute__((ext_vector_type(2)));
typedef __bf16 bf16x2_t __attribute__((ext_vector_type(2)));

constexpr int DM = 1024, SEQ = 8192, NB = 2, MP = NB * SEQ, NSB = 128, NSL = 8, MS = NSB * NSL, M = MP + MS;
constexpr int DFF = 2816, DPLE = 256, DSSM = 512, NG = 32, NP = 64, DIN = 4864;
constexpr int TCH = 32, NCH = SEQ / TCH, NCR = NB * NCH;
constexpr int UGP = 128 + TCH * 16;
constexpr float EPS = 1e-6f, LOG2E = 1.4426950408889634f, QSCALE = 0.125f * 1.4426950408889634f;

constexpr size_t O_Y = 0, O_KVP0 = (size_t)M * DM, O_KVP1 = O_KVP0 + 131072, O_KVP2 = O_KVP1 + 524288, O_SSMP = O_KVP2 + 2097152,
                 O_KVS0 = O_SSMP + 8192, O_KVS1 = O_KVS0 + 524288, O_KVS2 = O_KVS1 + 524288, O_SSMS = O_KVS2 + 524288, O_END = O_SSMS + 524288;

constexpr size_t MiB = 1u << 20;
constexpr size_t WS_CTL = 0, CTL_ZERO_BYTES = 1 * MiB;
constexpr size_t WS_SSQ = 512 * 1024;
constexpr size_t WS_W1GU = 2 * MiB, WS_W1D = 14 * MiB, WS_WIN = 20 * MiB, WS_WGLU = 30 * MiB, WS_WBS = 31 * MiB, WS_WBA = 32 * MiB, WS_WOUT = 33 * MiB,
                 WS_W2GU = 36 * MiB, WS_W2D = 48 * MiB, WS_WPG = 54 * MiB, WS_WPP = 57 * MiB, WS_WM = 58 * MiB, WS_B2 = 67 * MiB, WS_BS = 88 * MiB,
                 WS_KTAB = 93 * MiB, WS_POW = 95 * MiB, WS_BBAR = 96 * MiB;
constexpr size_t WS_XB = 100 * MiB, WS_HID = 136 * MiB, WS_QB = 232 * MiB, WS_KB = 258 * MiB, WS_VB = 284 * MiB, WS_SA = 310 * MiB, WS_SB = 346 * MiB,
                 WS_UGX = 382 * MiB, WS_USX = 403 * MiB, WS_SC = 406 * MiB, WS_YS = 415 * MiB, WS_YG = 433 * MiB, WS_OG = 451 * MiB, WS_LSE = 478 * MiB,
                 WS_YATT = 480 * MiB, WS_TMP = 490 * MiB, WS_MRG = 526 * MiB, WS_PP = 562 * MiB, WS_PB = 598 * MiB, WS_END = 608 * MiB;
static_assert(WS_W1GU + (size_t)5632 * 1024 * 2 <= WS_W1D && WS_W1D + (size_t)1024 * 2816 * 2 <= WS_WIN && WS_WIN + (size_t)DIN * 1024 * 2 <= WS_WGLU, "ws map 1");
static_assert(WS_WM + (size_t)NG * 256 * 512 * 2 <= WS_B2 && WS_B2 + (size_t)NG * 512 * UGP * 2 <= WS_BS && WS_BS + (size_t)NG * 256 * 256 * 2 <= WS_KTAB, "ws map 2");
static_assert(WS_XB + (size_t)M * DM * 2 <= WS_HID && WS_HID + (size_t)M * DFF * 2 <= WS_QB && WS_QB + (size_t)M * 768 * 2 <= WS_KB && WS_SA + (size_t)M * DM * 2 <= WS_SB, "ws map 3");
static_assert(WS_UGX + (size_t)NG * NCR * UGP * 2 <= WS_USX && WS_USX + (size_t)(NG + 1) * 128 * 256 * 2 <= WS_SC && WS_SC + (size_t)NG * NCR * 128 * 4 <= WS_YS, "ws map 4");
static_assert(WS_YS + (size_t)M * 512 * 2 <= WS_YG && WS_OG + (size_t)3 * M * 256 * 2 <= WS_LSE && WS_LSE + (size_t)3 * M * 4 * 4 <= WS_YATT && WS_YATT + (size_t)M * 256 * 2 <= WS_TMP, "ws map 5");
static_assert(WS_PB + (size_t)M * 256 * 2 <= WS_END && 5 * (size_t)M * 4 + WS_SSQ <= CTL_ZERO_BYTES, "ws map 6");
constexpr int CW_BAR = 4096;

constexpr int RING_BYTES = 131072, LDSCTL_OFF = RING_BYTES, MISC_OFF = LDSCTL_OFF + 320, LDS_BYTES = 147456;
constexpr int NWAVES = 8;

__device__ __forceinline__ unsigned cvtpk(float lo, float hi) { f32x2 v = {lo, hi}; bf16x2_t b = __builtin_convertvector(v, bf16x2_t); return __builtin_bit_cast(unsigned, b); }
__device__ __forceinline__ float bflo(unsigned w) { return __uint_as_float(w << 16); }
__device__ __forceinline__ float bfhi(unsigned w) { return __uint_as_float(w & 0xffff0000u); }
__device__ __forceinline__ u32x4 pack8(f32x4 a, f32x4 b) { u32x4 w; w.x = cvtpk(a[0], a[1]); w.y = cvtpk(a[2], a[3]); w.z = cvtpk(b[0], b[1]); w.w = cvtpk(b[2], b[3]); return w; }
__device__ __forceinline__ void unpack8(u32x4 w, f32x4& a, f32x4& b) { a = (f32x4){bflo(w.x), bfhi(w.x), bflo(w.y), bfhi(w.y)}; b = (f32x4){bflo(w.z), bfhi(w.z), bflo(w.w), bfhi(w.w)}; }
__device__ __forceinline__ float sigmoidf_(float x) { return __builtin_amdgcn_rcpf(1.f + __builtin_amdgcn_exp2f(-x * LOG2E)); }
__device__ __forceinline__ f32x4 sigmoid4(f32x4 v) { return (f32x4){sigmoidf_(v[0]), sigmoidf_(v[1]), sigmoidf_(v[2]), sigmoidf_(v[3])}; }
__device__ __forceinline__ float gelu_tanh(float y) { const float z2 = 1.5957691216057308f * (y + 0.044715f * y * y * y); return y * sigmoidf_(z2); }
__device__ __forceinline__ f32x4 gelu4(f32x4 v) { return (f32x4){gelu_tanh(v[0]), gelu_tanh(v[1]), gelu_tanh(v[2]), gelu_tanh(v[3])}; }
__device__ __forceinline__ float rs_of(float ssq) { return __builtin_amdgcn_rsqf(ssq * (1.f / DM) + EPS); }
#define LDS_WAIT() asm volatile("s_waitcnt lgkmcnt(0)" ::: "memory")
#define VM_WAIT() asm volatile("s_waitcnt vmcnt(0)" ::: "memory")

namespace pg8 {
constexpr int BM = 256, BK = 64, HALF = 128, HTB = HALF * BK * 2, NXCD = 8, WGM = 8;
__device__ __forceinline__ int lds_byte(int r, int c) { const int st = (r >> 4) * 2 + (c >> 5), rr = r & 15, cc = c & 31, ob = rr * 64 + cc * 2; return st * 1024 + (ob ^ (((ob >> 9) & 1) << 5)); }
__device__ __forceinline__ void stage_rc(int b, int& R, int& C) { const int st = b / 1024, sb = b % 1024, swz = sb ^ (((sb >> 9) & 1) << 5); R = (st >> 1) * 16 + swz / 64; C = (st & 1) * 32 + (swz % 64) / 2; }
__device__ __forceinline__ int perm32(int rho) { const int n = rho >> 4, i = rho & 15; return 8 * (i >> 2) + 4 * n + (i & 3); }

struct Unit { int pm, pn, g; };
template <int nM, int nN, int nG> struct Order {
    static constexpr int nwg = nM * nN * nG;
    int G, c;
    __device__ __forceinline__ void init(int G_, int c_, int c0) { G = G_; c = (c_ - c0 % G_ + G_) % G_; }
    __device__ __forceinline__ bool next(int i, Unit& u) const {
        const long L = (long)i * G + c; if (L >= nwg) return false;
        int wgid = (int)L;
        if constexpr (nG == 1) {
            { constexpr int q = nwg / NXCD, r = nwg % NXCD; const int xcd = wgid % NXCD, off = wgid / NXCD; wgid = (xcd < r ? xcd * (q + 1) : r * (q + 1) + (xcd - r) * q) + off; }
            constexpr int nig = WGM * nN; const int gid = wgid / nig, fm = gid * WGM, gsz = (nM - fm) < WGM ? (nM - fm) : WGM;
            u.pm = fm + ((wgid % nig) % gsz); u.pn = (wgid % nig) / gsz; u.g = 0;
        } else { u.g = wgid / (nM * nN); const int r = wgid % (nM * nN); u.pm = r / nN; u.pn = r % nN; }
        return true;
    }
};

template <class C, class Epi>
__device__ __forceinline__ void gemm_phase(LAS unsigned char* lds, const bf16_t* gA, const bf16_t* gBt, int Gsz, int cu, int c0, const Epi& E) {
    const int tid = threadIdx.x, wid = __builtin_amdgcn_readfirstlane(tid >> 6), lane = tid & 63, wr = wid >> 2, wc = wid & 3, fr = lane & 15, fq = lane >> 4;
    constexpr int nt = C::KK / BK;
    struct { const bf16_t* A; const bf16_t* Bt; } g{gA, gBt};
    Order<C::NM, C::NN, C::NGRP> S; S.init(Gsz, cu, c0);
    unsigned voffA[2], voffB[2];
#pragma unroll
    for (int i = 0; i < 2; ++i) { int R, Cc; stage_rc(tid * 16 + i * 8192, R, Cc); const int Rb = (R & ~31) + perm32(R & 31);
        voffA[i] = (unsigned)(R * C::LDA + Cc) * 2u; voffB[i] = (unsigned)(Rb * C::LDB + Cc) * 2u; }
    constexpr size_t kstep = (size_t)(BK * 2);
    constexpr size_t hstepA = (size_t)HALF * C::LDA * 2, hstepB = (size_t)HALF * C::LDB * 2;
    const unsigned ldsw = (unsigned)wid * 1024u;
    const int aoff = lds_byte(wr * 64 + fr, fq * 8), boff = lds_byte(wc * 32 + fr, fq * 8);
#define PG8_SA(b, h) (((b) * 2 + (h)) * HTB)
#define PG8_SB(b, h) ((4 + (b) * 2 + (h)) * HTB)
#define PG8_STAGE(bufoff, gbase, voff) do { _Pragma("unroll") for (int _i = 0; _i < 2; ++_i) \
        __builtin_amdgcn_global_load_lds((const unsigned*)((const char*)(gbase) + (voff)[_i]), (LAS unsigned*)(lds + (bufoff) + ldsw + _i * 8192), 16, 0, 0); } while (0)
#define PG8_LDA(dst, b, h) do { _Pragma("unroll") for (int m = 0; m < 4; ++m) _Pragma("unroll") for (int k = 0; k < 2; ++k) dst[m][k] = *(const LAS bf16x8*)(lds + PG8_SA(b, h) + aoff + m * 2048 + k * 1024); } while (0)
#define PG8_LDB(dst, b, h) do { _Pragma("unroll") for (int n = 0; n < 2; ++n) _Pragma("unroll") for (int k = 0; k < 2; ++k) dst[n][k] = *(const LAS bf16x8*)(lds + PG8_SB(b, h) + boff + n * 2048 + k * 1024); } while (0)
#define PG8_MMA(ai, bj, At, Bt) do { __builtin_amdgcn_s_setprio(1); _Pragma("unroll") for (int m = 0; m < 4; ++m) _Pragma("unroll") for (int n = 0; n < 2; ++n) _Pragma("unroll") for (int k = 0; k < 2; ++k) \
        acc[ai][bj][m][n] = __builtin_amdgcn_mfma_f32_16x16x32_bf16(Bt[n][k], At[m][k], acc[ai][bj][m][n], 0, 0, 0); __builtin_amdgcn_s_setprio(0); } while (0)
#define PG8_WAIT_V(n) asm volatile("s_waitcnt vmcnt(" #n ")" ::: "memory")
#define PG8_WAIT_L(n) asm volatile("s_waitcnt lgkmcnt(" #n ")" ::: "memory")
#define PG8_BAR __builtin_amdgcn_s_barrier()
#define PG8_SCHED __builtin_amdgcn_sched_barrier(0)
    Unit cur, nxt; int ui = 0;
    if (!S.next(0, cur)) return;
    f32x4 acc[2][2][4][2];
#pragma unroll
    for (int a = 0; a < 2; ++a)
#pragma unroll
        for (int b = 0; b < 2; ++b)
#pragma unroll
            for (int m = 0; m < 4; ++m)
#pragma unroll
                for (int n = 0; n < 2; ++n) acc[a][b][m][n] = (f32x4){0.f, 0.f, 0.f, 0.f};
    bf16x8 At[4][2], B0[2][2], B1[2][2];
    const char* cA = (const char*)(g.A + (size_t)cur.g * C::GSA) + (size_t)cur.pm * 2 * hstepA; const char* cB = (const char*)(g.Bt + (size_t)cur.g * C::GSB) + (size_t)cur.pn * 2 * hstepB;
    PG8_STAGE(PG8_SB(0, 0), cB, voffB); PG8_STAGE(PG8_SB(0, 1), cB + hstepB, voffB); PG8_STAGE(PG8_SA(0, 0), cA, voffA); PG8_STAGE(PG8_SA(0, 1), cA + hstepA, voffA);
    if (wr == 1) PG8_BAR;
    PG8_WAIT_V(2); PG8_BAR;
    PG8_STAGE(PG8_SB(1, 0), cB + kstep, voffB); PG8_STAGE(PG8_SA(1, 0), cA + kstep, voffA); PG8_STAGE(PG8_SB(1, 1), cB + hstepB + kstep, voffB);
    PG8_WAIT_V(6); PG8_BAR;
    for (;;) {
        const bool has_next = S.next(ui + 1, nxt);
        const char* nA = has_next ? (const char*)(g.A + (size_t)nxt.g * C::GSA) + (size_t)nxt.pm * 2 * hstepA : cA;
        const char* nB = has_next ? (const char*)(g.Bt + (size_t)nxt.g * C::GSB) + (size_t)nxt.pn * 2 * hstepB : cB;
#pragma unroll 1
        for (int t = 0; t < nt; t += 2) {
            const bool last = (t == nt - 2);
            const char* a1 = cA + (size_t)(t + 1) * kstep;
            const char* a2 = last ? nA : cA + (size_t)(t + 2) * kstep; const char* b2 = last ? nB : cB + (size_t)(t + 2) * kstep;
            const char* a3 = a2 + kstep; const char* b3 = b2 + kstep;
            PG8_LDB(B0, 0, 0); PG8_LDB(B1, 0, 1); PG8_SCHED; PG8_LDA(At, 0, 0); PG8_STAGE(PG8_SA(1, 1), a1 + hstepA, voffA);
            PG8_WAIT_V(8); PG8_WAIT_L(0); PG8_BAR; PG8_MMA(0, 0, At, B0); PG8_MMA(0, 1, At, B1); PG8_BAR; PG8_SCHED;
            PG8_LDA(At, 0, 1); PG8_STAGE(PG8_SB(0, 0), b2, voffB); PG8_STAGE(PG8_SB(0, 1), b2 + hstepB, voffB); PG8_STAGE(PG8_SA(0, 0), a2, voffA);
            PG8_WAIT_V(8); PG8_WAIT_L(0); PG8_BAR; PG8_MMA(1, 0, At, B0); PG8_MMA(1, 1, At, B1); PG8_BAR; PG8_SCHED;
            PG8_LDB(B0, 1, 0); PG8_LDB(B1, 1, 1); PG8_SCHED; PG8_LDA(At, 1, 0); PG8_STAGE(PG8_SA(0, 1), a2 + hstepA, voffA);
            PG8_WAIT_V(8); PG8_WAIT_L(0); PG8_BAR; PG8_MMA(0, 0, At, B0); PG8_MMA(0, 1, At, B1); PG8_BAR; PG8_SCHED;
            PG8_LDA(At, 1, 1); PG8_STAGE(PG8_SB(1, 0), b3, voffB); PG8_STAGE(PG8_SB(1, 1), b3 + hstepB, voffB); PG8_STAGE(PG8_SA(1, 0), a3, voffA);
            PG8_WAIT_V(8); PG8_WAIT_L(0); PG8_BAR; PG8_MMA(1, 0, At, B0); PG8_MMA(1, 1, At, B1); PG8_BAR; PG8_SCHED;
        }
        if (wr == 0) PG8_BAR;
        E(acc, cur, wr, wc, fr, fq);
        if (!has_next) break;
#pragma unroll
        for (int a = 0; a < 2; ++a)
#pragma unroll
            for (int b = 0; b < 2; ++b)
#pragma unroll
                for (int m = 0; m < 4; ++m)
#pragma unroll
                    for (int n = 0; n < 2; ++n) acc[a][b][m][n] = (f32x4){0.f, 0.f, 0.f, 0.f};
        cur = nxt; cA = nA; cB = nB; ++ui;
        if (wr == 1) PG8_BAR;
    }
    PG8_WAIT_V(0);
    PG8_BAR;
#undef PG8_SA
#undef PG8_SB
#undef PG8_STAGE
#undef PG8_LDA
#undef PG8_LDB
#undef PG8_MMA
#undef PG8_WAIT_V
#undef PG8_WAIT_L
#undef PG8_BAR
#undef PG8_SCHED
}
}

enum { EK_SWIGLU = 1, EK_RESID, EK_PLE, EK_WIN, EK_S1, EK_S2, EK_SS, EK_GLU, EK_M1, EK_M2, EK_PP };
struct EpiArgs {
    unsigned char* ws; float* out;
    const float* base0; const float* base1;
    const float* dskip;
    int ssq_i, ssq_o;
    float alpha;
};
#define WSP(T, off) ((T*)(a.ws + (off)))
template <int KIND> struct Epi {
    EpiArgs a;
    __device__ __forceinline__ void operator()(f32x4 (&acc)[2][2][4][2], const pg8::Unit& u, int wr, int wc, int fr, int fq) const {
        const int c8t = wc * 32 + 8 * fq;
#pragma unroll
        for (int ai = 0; ai < 2; ++ai)
#pragma unroll
            for (int m = 0; m < 4; ++m) {
                const int row = u.pm * 256 + ai * 128 + wr * 64 + m * 16 + fr;
                if constexpr (KIND == EK_SWIGLU) {
                    const float rs = rs_of(WSP(const float, WS_SSQ)[(size_t)a.ssq_i * M + row]);
                    const f32x4 g0 = acc[ai][0][m][0] * rs, g1 = acc[ai][0][m][1] * rs, u0 = acc[ai][1][m][0] * rs, u1 = acc[ai][1][m][1] * rs;
                    const f32x4 h0 = g0 * sigmoid4(g0) * u0, h1 = g1 * sigmoid4(g1) * u1;
                    *(u32x4*)(WSP(bf16_t, WS_HID) + (size_t)row * DFF + u.pn * 128 + c8t) = pack8(h0, h1);
                } else if constexpr (KIND == EK_RESID || KIND == EK_PLE) {
                    const float* bp = row < MP ? a.base0 + (size_t)row * DM : a.base1 + (size_t)(row - MP) * DM;
                    float rs = 0.f; if constexpr (KIND == EK_PLE) rs = rs_of(WSP(const float, WS_SSQ)[(size_t)a.ssq_i * M + row]);
                    float sq = 0.f;
#pragma unroll
                    for (int bj = 0; bj < 2; ++bj) {
                        const int col = u.pn * 256 + bj * 128 + c8t;
                        const f32x4 b0 = *(const f32x4*)(bp + col), b1 = *(const f32x4*)(bp + col + 4);
                        f32x4 v0, v1;
                        if constexpr (KIND == EK_PLE) { f32x4 p0, p1; unpack8(*(const u32x4*)(WSP(const bf16_t, WS_PP) + (size_t)row * DM + col), p0, p1);
                            v0 = b0 + sigmoid4(acc[ai][bj][m][0] * rs) * p0; v1 = b1 + sigmoid4(acc[ai][bj][m][1] * rs) * p1; }
                        else { v0 = b0 + a.alpha * acc[ai][bj][m][0]; v1 = b1 + a.alpha * acc[ai][bj][m][1]; }
                        *(f32x4*)(a.out + (size_t)row * DM + col) = v0; *(f32x4*)(a.out + (size_t)row * DM + col + 4) = v1;
                        if constexpr (KIND == EK_RESID) *(u32x4*)(WSP(bf16_t, WS_XB) + (size_t)row * DM + col) = pack8(v0, v1);
                        sq += (v0[0] * v0[0] + v0[1] * v0[1]) + (v0[2] * v0[2] + v0[3] * v0[3]) + (v1[0] * v1[0] + v1[1] * v1[1]) + (v1[2] * v1[2] + v1[3] * v1[3]);
                    }
                    sq += __shfl_xor(sq, 16); sq += __shfl_xor(sq, 32);
                    if (fq == 0) atomicAdd(WSP(float, WS_SSQ) + (size_t)a.ssq_o * M + row, sq);
                } else if constexpr (KIND == EK_WIN) {
                    const float rs = rs_of(WSP(const float, WS_SSQ)[(size_t)a.ssq_i * M + row]);
                    const int pn = u.pn;
#pragma unroll
                    for (int bj = 0; bj < 2; ++bj) {
                        const int c8 = bj * 128 + c8t;
                        f32x4 v0 = acc[ai][bj][m][0] * rs, v1 = acc[ai][bj][m][1] * rs;
                        if (pn < 2) {
                            const int col = pn * 256 + c8, grp = col >> 4, ch0 = col & 15;
                            bf16_t* dst = row < MP ? WSP(bf16_t, WS_UGX) + ((size_t)grp * NCR + (row >> 5)) * UGP + 128 + (row & 31) * 16 + ch0
                                                   : WSP(bf16_t, WS_USX) + ((size_t)grp * 128 + ((row - MP) >> 3)) * 256 + 128 + ((row - MP) & 7) * 16 + ch0;
                            *(u32x4*)dst = pack8(v0, v1);
                        } else if (pn < 5) {
                            *(u32x4*)(WSP(bf16_t, WS_QB) + (size_t)row * 768 + (pn - 2) * 256 + c8) = pack8(v0 * QSCALE, v1 * QSCALE);
                        } else if (pn < 11) {
                            const int kvsel = pn >= 8 ? 1 : 0, gq = (pn - 5) % 3, keep = 128 << (2 * gq);
                            *(u32x4*)(WSP(bf16_t, (kvsel ? WS_VB : WS_KB)) + (size_t)row * 768 + gq * 256 + c8) = pack8(v0, v1);
                            float* fo = nullptr;
                            if (row >= MP) fo = a.out + (gq == 0 ? O_KVS0 : gq == 1 ? O_KVS1 : O_KVS2) + ((size_t)(row - MP) * 2 + kvsel) * 256 + c8;
                            else { const int b = row >> 13, t = row & (SEQ - 1); if (t >= SEQ - keep) fo = a.out + (gq == 0 ? O_KVP0 : gq == 1 ? O_KVP1 : O_KVP2) + (((size_t)b * keep + (t - (SEQ - keep))) * 2 + kvsel) * 256 + c8; }
                            if (fo) { *(f32x4*)fo = v0; *(f32x4*)(fo + 4) = v1; }
                        } else {
                            *(u32x4*)(WSP(bf16_t, (pn < 15 ? WS_SA : WS_SB)) + (size_t)row * DM + ((pn - 11) & 3) * 256 + c8) = pack8(sigmoid4(v0), sigmoid4(v1));
                        }
                    }
                } else if constexpr (KIND == EK_S1) {
                    if (u.pn == 0) { float* d = WSP(float, WS_SC) + ((size_t)u.g * NCR + row) * 128 + c8t; *(f32x4*)d = acc[ai][0][m][0]; *(f32x4*)(d + 4) = acc[ai][0][m][1]; }
                } else if constexpr (KIND == EK_S2) {
#pragma unroll
                    for (int bj = 0; bj < 2; ++bj) {
                        const int col = u.pn * 256 + bj * 128 + c8t, t = col >> 4, ch0 = col & 15;
                        f32x4 u0, u1; unpack8(*(const u32x4*)(WSP(const bf16_t, WS_UGX) + ((size_t)u.g * NCR + row) * UGP + 128 + t * 16 + ch0), u0, u1);
                        const f32x4 d0 = *(const f32x4*)(a.dskip + u.g * 16 + ch0), d1 = *(const f32x4*)(a.dskip + u.g * 16 + ch0 + 4);
                        const f32x4 y0 = gelu4(acc[ai][bj][m][0] + d0 * u0), y1 = gelu4(acc[ai][bj][m][1] + d1 * u1);
                        *(u32x4*)(WSP(bf16_t, WS_YS) + ((size_t)row * TCH + t) * DSSM + u.g * 16 + ch0) = pack8(y0, y1);
                    }
                } else if constexpr (KIND == EK_SS) {
                    if (ai == 0) {
                        const int n = row;
                        { const int col = c8t, l = col >> 4, ch0 = col & 15;
                          f32x4 u0, u1; unpack8(*(const u32x4*)(WSP(const bf16_t, WS_USX) + ((size_t)u.g * 128 + n) * 256 + 128 + l * 16 + ch0), u0, u1);
                          const f32x4 d0 = *(const f32x4*)(a.dskip + u.g * 16 + ch0), d1 = *(const f32x4*)(a.dskip + u.g * 16 + ch0 + 4);
                          const f32x4 y0 = gelu4(acc[0][0][m][0] + d0 * u0), y1 = gelu4(acc[0][0][m][1] + d1 * u1);
                          *(u32x4*)(WSP(bf16_t, WS_YS) + ((size_t)(MP + n * 8 + l)) * DSSM + u.g * 16 + ch0) = pack8(y0, y1); }
                        { float* d = a.out + O_SSMS + ((size_t)n * NG + u.g) * 128 + c8t; *(f32x4*)d = acc[0][1][m][0]; *(f32x4*)(d + 4) = acc[0][1][m][1]; }
                    }
                } else if constexpr (KIND == EK_GLU) {
#pragma unroll
                    for (int bj = 0; bj < 2; ++bj) { const int col = u.pn * 256 + bj * 128 + c8t;
                        f32x4 y0, y1; unpack8(*(const u32x4*)(WSP(const bf16_t, WS_YS) + (size_t)row * DSSM + col), y0, y1);
                        *(u32x4*)(WSP(bf16_t, WS_YG) + (size_t)row * DSSM + col) = pack8(y0 * sigmoid4(acc[ai][bj][m][0]), y1 * sigmoid4(acc[ai][bj][m][1])); }
                } else if constexpr (KIND == EK_M1 || KIND == EK_M2) {
#pragma unroll
                    for (int bj = 0; bj < 2; ++bj) { const int col = u.pn * 256 + bj * 128 + c8t;
                        f32x4 s0, s1; unpack8(*(const u32x4*)(WSP(const bf16_t, (KIND == EK_M1 ? WS_SA : WS_SB)) + (size_t)row * DM + col), s0, s1);
                        f32x4 v0 = s0 * acc[ai][bj][m][0], v1 = s1 * acc[ai][bj][m][1];
                        if constexpr (KIND == EK_M2) { f32x4 t0, t1; unpack8(*(const u32x4*)(WSP(const bf16_t, WS_TMP) + (size_t)row * DM + col), t0, t1); v0 += t0; v1 += t1; }
                        *(u32x4*)(WSP(bf16_t, (KIND == EK_M1 ? WS_TMP : WS_MRG)) + (size_t)row * DM + col) = pack8(v0, v1); }
                } else if constexpr (KIND == EK_PP) {
#pragma unroll
                    for (int bj = 0; bj < 2; ++bj) { const int col = u.pn * 256 + bj * 128 + c8t;
                        *(u32x4*)(WSP(bf16_t, WS_PP) + (size_t)row * DM + col) = pack8(acc[ai][bj][m][0], acc[ai][bj][m][1]); }
                }
            }
    }
};


#define DEFCFG(NAME, KIND_, LDA_, LDB_, KK_, NM_, NN_, NGRP_, GSA_, GSB_) struct NAME { static constexpr int KIND = KIND_, LDA = LDA_, LDB = LDB_, KK = KK_, NM = NM_, NN = NN_, NGRP = NGRP_; static constexpr long GSA = GSA_, GSB = GSB_; }
DEFCFG(CfgGU,   EK_SWIGLU, DM,   DM,   DM,   M / 256, 22, 1, 0, 0);
DEFCFG(CfgPP,   EK_PP,     DPLE, DPLE, DPLE, M / 256, 4,  1, 0, 0);
DEFCFG(CfgDown, EK_RESID,  DFF,  DFF,  DFF,  M / 256, 4,  1, 0, 0);
DEFCFG(CfgWin,  EK_WIN,    DM,   DM,   DM,   M / 256, 19, 1, 0, 0);
DEFCFG(CfgS1,   EK_S1,     UGP,  512,  512,  2, 1, NG, (long)NCR * UGP, 256L * 512);
DEFCFG(CfgSS,   EK_SS,     256,  256,  256,  1, 1, NG, 128L * 256, 256L * 256);
DEFCFG(CfgS2,   EK_S2,     UGP,  UGP,  UGP,  2, 2, NG, (long)NCR * UGP, 512L * UGP);
DEFCFG(CfgGLU,  EK_GLU,    DSSM, DSSM, DSSM, M / 256, 2,  1, 0, 0);
DEFCFG(CfgM1,   EK_M1,     DSSM, DSSM, DSSM, M / 256, 4,  1, 0, 0);
DEFCFG(CfgM2,   EK_M2,     256,  256,  256,  M / 256, 4,  1, 0, 0);
DEFCFG(CfgOut,  EK_RESID,  DM,   DM,   DM,   M / 256, 4,  1, 0, 0);
DEFCFG(CfgPle,  EK_PLE,    DM,   DM,   DM,   M / 256, 4,  1, 0, 0);

typedef GAS unsigned gu32;
#define RLX_AGENT __ATOMIC_RELAXED, __HIP_MEMORY_SCOPE_AGENT
#define XB_TMO      128
#define XB_XCNT(j)  (256  + 64 * (j))
#define XB_XSUB(j)  (1280 + 64 * (j))
#define XB_XGEN(j)  (2304 + 64 * (j))
#define XB_TOP      3328
#define XB_TOPGEN   3392
#define XCD_BAR_WORDS 3456
#define XB_SPIN_CAP (1u << 18)
__device__ __forceinline__ unsigned xb_ld(unsigned* p)              { return __hip_atomic_load(p, __ATOMIC_RELAXED, __HIP_MEMORY_SCOPE_AGENT); }
__device__ __forceinline__ unsigned xb_add(unsigned* p, unsigned v) { return __hip_atomic_fetch_add(p, v, __ATOMIC_RELAXED, __HIP_MEMORY_SCOPE_AGENT); }
__device__ __forceinline__ unsigned xb_xcc_id() { return (unsigned)__builtin_amdgcn_s_getreg((3 << 11) | 20) & 0xFu; }
#define XB_SPIN(cond, bar) do { unsigned _sp = 0; while (cond) { __builtin_amdgcn_s_sleep(1); \
    if ((++_sp & 255u) == 0u) { if (xb_ld(&(bar)[XB_TMO])) break; if (_sp > XB_SPIN_CAP) { atomicAdd(&(bar)[XB_TMO], 1u); break; } } } } while (0)
struct XcdBarrier { unsigned* bar; unsigned x; volatile LAS unsigned* st; };
__device__ __forceinline__ XcdBarrier xcd_barrier_post(unsigned* bar, volatile LAS unsigned* st) {
    XcdBarrier b; b.bar = bar; b.x = xb_xcc_id(); b.st = st;
    if (threadIdx.x == 0) (void)xb_add(&bar[XB_XCNT(b.x)], 1u);
    return b;
}
__device__ __forceinline__ void xcd_barrier_complete(unsigned* bar, unsigned x, unsigned& nloc, unsigned& nx) {
    const unsigned G = gridDim.x * gridDim.y * gridDim.z;
    unsigned sum, cnt, mine, sp = 0u;
    for (;;) {
        sum = 0u; cnt = 0u; mine = 0u;
#pragma unroll
        for (unsigned j = 0; j < 16; ++j) { const unsigned c = xb_ld(&bar[XB_XCNT(j)]); sum += c; cnt += (c > 0u) ? 1u : 0u; mine = (j == x) ? c : mine; }
        if (sum == G) break;
        __builtin_amdgcn_s_sleep(1);
        if ((++sp & 255u) == 0u) { if (xb_ld(&bar[XB_TMO])) break; if (sp > XB_SPIN_CAP) { atomicAdd(&bar[XB_TMO], 1u); break; } }
    }
    nloc = mine > 0u ? mine : 1u; nx = cnt > 0u ? cnt : 1u;
}
__device__ __forceinline__ void xcd_barrier(const XcdBarrier& b) {
    asm volatile("s_waitcnt vmcnt(0)" ::: "memory");
    __syncthreads();
    if (threadIdx.x == 0) {
        unsigned* bar = b.bar;
        __builtin_amdgcn_s_waitcnt(0);
        unsigned nloc = b.st[0], nx = b.st[1];
        if (nloc == 0u) { xcd_barrier_complete(bar, b.x, nloc, nx); b.st[0] = nloc; b.st[1] = nx; }
        const unsigned old = xb_add(&bar[XB_XSUB(b.x)], 1u);
        const unsigned gen = old / nloc;
        if (old + 1u == (gen + 1u) * nloc) {
            __builtin_amdgcn_fence(__ATOMIC_RELEASE, "agent");
            asm volatile("s_waitcnt vmcnt(0)" ::: "memory");
            const unsigned og = xb_add(&bar[XB_TOP], 1u);
            const unsigned tg = og / nx;
            if (og + 1u == (tg + 1u) * nx) xb_add(&bar[XB_TOPGEN], 1u);
            else XB_SPIN(xb_ld(&bar[XB_TOPGEN]) == tg, bar);
            __builtin_amdgcn_fence(__ATOMIC_ACQUIRE, "agent");
            xb_add(&bar[XB_XGEN(b.x)], 1u);
            asm volatile("s_waitcnt vmcnt(0)" ::: "memory");
        } else {
            XB_SPIN(xb_ld(&bar[XB_XGEN(b.x)]) == gen, bar);
            __builtin_amdgcn_fence(__ATOMIC_ACQUIRE, "agent");
            asm volatile("s_waitcnt vmcnt(0)" ::: "memory");
        }
    }
    __syncthreads();
}


struct Args { const float* in[34]; float* out; unsigned char* ws; int ph_lo, ph_hi; };

struct Frame {
    LAS unsigned char* lds; int tid, lane, wave, G, gw, NGW;
};
typedef const float* cfp_t;
typedef const __attribute__((address_space(4))) Args* KArgs;
__device__ __forceinline__ KArgs kargs() { KArgs p = (KArgs)__builtin_amdgcn_kernarg_segment_ptr(); asm volatile("" : "+s"(p)); return p; }
__device__ __forceinline__ float wave_sum(float v) {
#pragma unroll
    for (int o = 1; o < 64; o <<= 1) v += __shfl_xor(v, o);
    return v;
}

__device__ __forceinline__ void p0_transpose_item(const float* W, int K, int N, bf16_t* WT, int ldt, int k0, int n0, int dst_row0, const float* gk, LAS float* scr, int lane) {
#pragma unroll 8
    for (int i = 0; i < 32; ++i) { const int kk = 2 * i + (lane >> 5); float v = W[(size_t)(k0 + kk) * N + n0 + (lane & 31)]; if (gk) v *= gk[k0 + kk]; scr[kk * 33 + (lane & 31)] = v; }
    LDS_WAIT(); asm volatile("" ::: "memory");
    const int c = lane & 7;
#pragma unroll
    for (int j = 0; j < 4; ++j) { const int n = (lane >> 3) + 8 * j; const LAS float* s = scr + (8 * c) * 33 + n;
        u32x4 o; o.x = cvtpk(s[0 * 33], s[1 * 33]); o.y = cvtpk(s[2 * 33], s[3 * 33]); o.z = cvtpk(s[4 * 33], s[5 * 33]); o.w = cvtpk(s[6 * 33], s[7 * 33]);
        *(u32x4*)(WT + (size_t)(dst_row0 + n) * ldt + k0 + 8 * c) = o; }
    LDS_WAIT(); asm volatile("" ::: "memory");
}
struct WJob { const float* W; int K, N; bf16_t* WT; const float* gk; int mode; };
__device__ __forceinline__ void p0_wjob(const WJob& j, int item, LAS float* scr, int lane) {
    const int nblk = j.N / 32, kb = item / nblk, nb = item % nblk, n0 = 32 * nb;
    const int dst = j.mode == 0 ? n0 : (n0 / 128) * 256 + (n0 % 128) + (j.mode == 2 ? 128 : 0);
    p0_transpose_item(j.W, j.K, j.N, j.WT, j.K, 64 * kb, n0, dst, j.gk, scr, lane);
}

__device__ __forceinline__ double dexp(double x) {
    const double k = __builtin_rint(x * 1.4426950408889634074), r = __builtin_fma(-k, 6.93147180369123816490e-01, x) - k * 1.90821492927058770002e-10;
    double p = 1.0 / 479001600.0;
    p = p * r + 1.0 / 39916800.0; p = p * r + 1.0 / 3628800.0; p = p * r + 1.0 / 362880.0; p = p * r + 1.0 / 40320.0; p = p * r + 1.0 / 5040.0; p = p * r + 1.0 / 720.0;
    p = p * r + 1.0 / 120.0; p = p * r + 1.0 / 24.0; p = p * r + 1.0 / 6.0; p = p * r + 0.5; p = p * r + 1.0; p = p * r + 1.0;
    return __builtin_ldexp(p, (int)k);
}
__device__ __forceinline__ void dsincos(double a, double& s, double& c) {
    const double k = __builtin_rint(a * 0.63661977236758134308);
    double r = __builtin_fma(-k, 1.57079632673412561417e+00, a); r = __builtin_fma(-k, 6.07710050650619224932e-11, r);
    const double z = r * r;
    double sp = -1.0 / 1307674368000.0; sp = sp * z + 1.0 / 6227020800.0; sp = sp * z - 1.0 / 39916800.0; sp = sp * z + 1.0 / 362880.0; sp = sp * z - 1.0 / 5040.0; sp = sp * z + 1.0 / 120.0; sp = sp * z - 1.0 / 6.0; sp = sp * z * r + r;
    double cp = 1.0 / 20922789888000.0; cp = cp * z - 1.0 / 87178291200.0; cp = cp * z + 1.0 / 479001600.0; cp = cp * z - 1.0 / 3628800.0; cp = cp * z + 1.0 / 40320.0; cp = cp * z - 1.0 / 720.0; cp = cp * z + 1.0 / 24.0; cp = cp * z - 0.5; cp = cp * z + 1.0;
    const int q = ((int)k) & 3;
    s = (q == 0) ? sp : (q == 1) ? cp : (q == 2) ? -sp : -cp;
    c = (q == 0) ? cp : (q == 1) ? -sp : (q == 2) ? -cp : sp;
}
__device__ __forceinline__ void cpow_d(double are, double aim, double dt, int n, double& pr, double& pi) {
    const double mag = dexp((double)n * are * dt); double s, c; dsincos((double)n * aim * dt, s, c); pr = mag * c; pi = mag * s;
}
__device__ __forceinline__ void ffac_d(double are, double aim, double dt, double& fr, double& fi) {
    double er, ei; cpow_d(are, aim, dt, 1, er, ei);
    const double nr = er - 1.0, ni = ei, den = are * are + aim * aim;
    fr = (nr * are + ni * aim) / den; fi = (ni * are - nr * aim) / den;
}

__device__ __forceinline__ void phase_prologue(Frame& F) {
    KArgs ka = kargs(); const __attribute__((address_space(4))) cfp_t* in = ka->in; unsigned char* ws = ka->ws;
    LAS float* scr = (LAS float*)(F.lds + F.wave * 16384);
    int it = F.gw;
#define DOJOB(W_, K_, N_, WT_, GK_, MODE_) do { const WJob jb{W_, K_, N_, (bf16_t*)(ws + WT_), GK_, MODE_}; const int n_items = ((K_) / 64) * ((N_) / 32); \
        for (; it < n_items; it += F.NGW) p0_wjob(jb, it, scr, F.lane); it -= n_items; } while (0)
    DOJOB(in[9], DM, DFF, WS_W1GU, in[8], 1); DOJOB(in[10], DM, DFF, WS_W1GU, in[8], 2); DOJOB(in[11], DFF, DM, WS_W1D, nullptr, 0);
    DOJOB(in[13], DM, DIN, WS_WIN, in[12], 0); DOJOB(in[22], DSSM, DSSM, WS_WGLU, nullptr, 0); DOJOB(in[23], DSSM, DM, WS_WBS, nullptr, 0);
    DOJOB(in[24], 256, DM, WS_WBA, nullptr, 0); DOJOB(in[25], DM, DM, WS_WOUT, nullptr, 0);
    DOJOB(in[27], DM, DFF, WS_W2GU, in[26], 1); DOJOB(in[28], DM, DFF, WS_W2GU, in[26], 2); DOJOB(in[29], DFF, DM, WS_W2D, nullptr, 0);
    DOJOB(in[31], DM, DM, WS_WPG, in[30], 0); DOJOB(in[32], DPLE, DM, WS_WPP, nullptr, 0);
#undef DOJOB
    float* ssq0 = (float*)(ws + WS_SSQ);
    bf16_t* XB = (bf16_t*)(ws + WS_XB); bf16_t* PB = (bf16_t*)(ws + WS_PB);
    for (int m = F.gw; m < M; m += F.NGW) {
        const float* xr = m < MP ? in[0] + (size_t)m * DM : in[1] + (size_t)(m - MP) * DM;
        f32x4 v[4]; float s = 0.f;
#pragma unroll
        for (int j = 0; j < 4; ++j) { v[j] = ((const f32x4*)xr)[F.lane + 64 * j]; s += (v[j][0] * v[j][0] + v[j][1] * v[j][1]) + (v[j][2] * v[j][2] + v[j][3] * v[j][3]); }
        s = wave_sum(s);
        if (F.lane == 0) ssq0[m] = s;
#pragma unroll
        for (int j = 0; j < 4; ++j) { u32x2 w; w.x = cvtpk(v[j][0], v[j][1]); w.y = cvtpk(v[j][2], v[j][3]); ((u32x2*)(XB + (size_t)m * DM))[F.lane + 64 * j] = w; }
        const float* pr = m < MP ? in[2] + (size_t)m * DPLE : in[3] + (size_t)(m - MP) * DPLE;
        const f32x4 pv = ((const f32x4*)pr)[F.lane]; u32x2 w; w.x = cvtpk(pv[0], pv[1]); w.y = cvtpk(pv[2], pv[3]); ((u32x2*)(PB + (size_t)m * DPLE))[F.lane] = w;
    }
    bf16_t* USX = (bf16_t*)(ws + WS_USX);
    for (int i = F.gw; i < NSB * NG; i += F.NGW) { const int n = i / NG, g = i % NG;
        if (F.lane < 32) { const f32x4 v = ((const f32x4*)(in[7] + ((size_t)n * NG + g) * 128))[F.lane]; u32x2 w; w.x = cvtpk(v[0], v[1]); w.y = cvtpk(v[2], v[3]);
            ((u32x2*)(USX + ((size_t)g * 128 + n) * 256))[F.lane] = w; } }
    float* POW = (float*)(ws + WS_POW); float* BBAR = (float*)(ws + WS_BBAR); float* KTAB = (float*)(ws + WS_KTAB);
    for (int g = F.gw; g < NG; g += F.NGW) {
        const int p = F.lane; const double are = in[14][g * NP + p], aim = in[15][g * NP + p], dt = dexp((double)in[16][g]);
        for (int n = 0; n <= 32; ++n) { double pr, pi; cpow_d(are, aim, dt, n, pr, pi); POW[((size_t)(g * NP + p) * 33 + n) * 2] = (float)pr; POW[((size_t)(g * NP + p) * 33 + n) * 2 + 1] = (float)pi; }
        double fr, fi; ffac_d(are, aim, dt, fr, fi);
        for (int c = 0; c < 16; ++c) { const double br = in[17][(g * NP + p) * 16 + c], bi = in[18][(g * NP + p) * 16 + c];
            BBAR[((size_t)(g * NP + p) * 16 + c) * 2] = (float)(fr * br - fi * bi); BBAR[((size_t)(g * NP + p) * 16 + c) * 2 + 1] = (float)(fr * bi + fi * br); }
    }
    for (int i = F.gw; i < NG * TCH; i += F.NGW) {
        const int g = i / TCH, tau = i % TCH, p = F.lane;
        const double are = in[14][g * NP + p], aim = in[15][g * NP + p], dt = dexp((double)in[16][g]);
        double pr, pi, fr, fi; cpow_d(are, aim, dt, tau, pr, pi); ffac_d(are, aim, dt, fr, fi);
        const float gr = (float)(pr * fr - pi * fi), gi = (float)(pr * fi + pi * fr);
        LAS float* Mr = scr; LAS float* Mi = scr + 1024;
#pragma unroll
        for (int c = 0; c < 16; ++c) { const float br = in[17][(g * NP + p) * 16 + c], bi = in[18][(g * NP + p) * 16 + c]; Mr[p * 16 + c] = gr * br - gi * bi; Mi[p * 16 + c] = gr * bi + gi * br; }
        LDS_WAIT(); asm volatile("" ::: "memory");
#pragma unroll 1
        for (int o = 0; o < 4; ++o) { const int idx = o * 64 + F.lane, c = idx >> 4, c2 = idx & 15; float s = 0.f;
            for (int q = 0; q < NP; ++q) s += in[19][(g * 16 + c) * NP + q] * Mr[q * 16 + c2] - in[20][(g * 16 + c) * NP + q] * Mi[q * 16 + c2];
            KTAB[((size_t)(g * TCH + tau) * 16 + c) * 16 + c2] = s; }
        LDS_WAIT(); asm volatile("" ::: "memory");
    }
}

__device__ __forceinline__ void phase_build_ssm(Frame& F) {
    KArgs ka = kargs(); const __attribute__((address_space(4))) cfp_t* in = ka->in; unsigned char* ws = ka->ws;
    const float* POW = (const float*)(ws + WS_POW); const float* BBAR = (const float*)(ws + WS_BBAR); const float* KTAB = (const float*)(ws + WS_KTAB);
    bf16_t* WM = (bf16_t*)(ws + WS_WM); bf16_t* B2 = (bf16_t*)(ws + WS_B2); bf16_t* BS = (bf16_t*)(ws + WS_BS);
    const int gt = F.gw * 64 + F.lane, NT = F.NGW * 64;
    constexpr int N_WM = NG * 256 * 64, N_B2 = NG * 512 * 80, N_BS = NG * 256 * 32;
    for (int i = gt; i < N_WM + N_B2 + N_BS; i += NT) {
        float v[8];
        bf16_t* dst;
        if (i < N_WM) {
            const int g = i / (256 * 64), r = i % (256 * 64), n = r / 64, k8 = (r % 64) * 8; dst = WM + ((size_t)g * 256 + n) * 512 + k8;
            if (n < 128) { const int p = n >> 1, ri = n & 1, s = k8 >> 4, c0 = k8 & 15; const float pr = POW[((size_t)(g * NP + p) * 33 + (31 - s)) * 2], pi = POW[((size_t)(g * NP + p) * 33 + (31 - s)) * 2 + 1];
#pragma unroll
                for (int j = 0; j < 8; ++j) { const float br = BBAR[((size_t)(g * NP + p) * 16 + c0 + j) * 2], bi = BBAR[((size_t)(g * NP + p) * 16 + c0 + j) * 2 + 1]; v[j] = ri ? pr * bi + pi * br : pr * br - pi * bi; } }
            else {
#pragma unroll
                for (int j = 0; j < 8; ++j) v[j] = 0.f; }
        } else if (i < N_WM + N_B2) {
            const int i2 = i - N_WM, g = i2 / (512 * 80), r = i2 % (512 * 80), row = r / 80, k8 = (r % 80) * 8, t = row >> 4, c = row & 15; dst = B2 + ((size_t)g * 512 + row) * UGP + k8;
            if (k8 < 128) {
#pragma unroll
                for (int jj = 0; jj < 4; ++jj) { const int p = (k8 >> 1) + jj; const float pr = POW[((size_t)(g * NP + p) * 33 + (t + 1)) * 2], pi = POW[((size_t)(g * NP + p) * 33 + (t + 1)) * 2 + 1];
                    const float cr = in[19][(g * 16 + c) * NP + p], ci = in[20][(g * 16 + c) * NP + p]; v[2 * jj] = cr * pr - ci * pi; v[2 * jj + 1] = -(cr * pi + ci * pr); }
            } else { const int s = (k8 - 128) >> 4, c0 = (k8 - 128) & 15;
#pragma unroll
                for (int j = 0; j < 8; ++j) v[j] = s <= t ? KTAB[((size_t)(g * TCH + (t - s)) * 16 + c) * 16 + c0 + j] : 0.f; }
        } else {
            const int i2 = i - N_WM - N_B2, g = i2 / (256 * 32), r = i2 % (256 * 32), row = r / 32, k8 = (r % 32) * 8; dst = BS + ((size_t)g * 256 + row) * 256 + k8;
            if (row < 128) { const int t = row >> 4, c = row & 15;
                if (k8 < 128) {
#pragma unroll
                    for (int jj = 0; jj < 4; ++jj) { const int p = (k8 >> 1) + jj; const float pr = POW[((size_t)(g * NP + p) * 33 + (t + 1)) * 2], pi = POW[((size_t)(g * NP + p) * 33 + (t + 1)) * 2 + 1];
                        const float cr = in[19][(g * 16 + c) * NP + p], ci = in[20][(g * 16 + c) * NP + p]; v[2 * jj] = cr * pr - ci * pi; v[2 * jj + 1] = -(cr * pi + ci * pr); }
                } else { const int s = (k8 - 128) >> 4, c0 = (k8 - 128) & 15;
#pragma unroll
                    for (int j = 0; j < 8; ++j) v[j] = s <= t ? KTAB[((size_t)(g * TCH + (t - s)) * 16 + c) * 16 + c0 + j] : 0.f; }
            } else { const int p = (row - 128) >> 1, ri = row & 1;
                if (k8 < 128) { const float ar = POW[((size_t)(g * NP + p) * 33 + 8) * 2], ai = POW[((size_t)(g * NP + p) * 33 + 8) * 2 + 1];
#pragma unroll
                    for (int j = 0; j < 8; ++j) { const int p2 = (k8 + j) >> 1, ri2 = (k8 + j) & 1; v[j] = p2 != p ? 0.f : (ri == 0 ? (ri2 == 0 ? ar : -ai) : (ri2 == 0 ? ai : ar)); }
                } else { const int s = (k8 - 128) >> 4, c0 = (k8 - 128) & 15; const float pr = POW[((size_t)(g * NP + p) * 33 + (7 - s)) * 2], pi = POW[((size_t)(g * NP + p) * 33 + (7 - s)) * 2 + 1];
#pragma unroll
                    for (int j = 0; j < 8; ++j) { const float br = BBAR[((size_t)(g * NP + p) * 16 + c0 + j) * 2], bi = BBAR[((size_t)(g * NP + p) * 16 + c0 + j) * 2 + 1]; v[j] = ri ? pr * bi + pi * br : pr * br - pi * bi; } }
            }
        }
        u32x4 w; w.x = cvtpk(v[0], v[1]); w.y = cvtpk(v[2], v[3]); w.z = cvtpk(v[4], v[5]); w.w = cvtpk(v[6], v[7]);
        *(u32x4*)dst = w;
    }
}

constexpr int VROWB = 144;
__device__ __forceinline__ s16x4 vtr(LAS const unsigned char* p) { return __builtin_bit_cast(s16x4, __builtin_amdgcn_ds_read_tr16_b64_v4i16((LAS s16x4*)p)); }
__device__ __forceinline__ void attn_prompt_task(const bf16_t* QB, const bf16_t* KB, const bf16_t* VB, bf16_t* OG, float* LSE, int b, int g, int r, int h, int qt, LAS unsigned char* wl, int lane) {
    const int r32 = lane & 31, hi = lane >> 5, d = 1 << (2 * g), m0 = qt * 32;
    const long tok0 = (long)b * SEQ + r;
    const size_t coff = (size_t)g * 256 + h * 64;
    const bf16_t* qrow = QB + (size_t)(tok0 + (long)d * (m0 + r32)) * 768 + coff;
    bf16x8 qf[4];
#pragma unroll
    for (int ks = 0; ks < 4; ++ks) qf[ks] = *(const bf16x8*)(qrow + 16 * ks + 8 * hi);
    float m_run = -1e30f, l_run = 0.f; f32x16 o0 = {}, o1 = {};
    const int vkey = lane >> 3, vch = lane & 7;
    const int trq = (lane & 15) >> 2, trp = lane & 3, trc = 16 * ((lane >> 4) & 1) + 4 * trp;
#pragma unroll 1
    for (int kt = 4; kt >= 0; --kt) {
        const int kp0 = m0 - 128 + 32 * kt; if (kp0 < 0) continue;
        u32x4 vv[4];
#pragma unroll
        for (int i4 = 0; i4 < 4; ++i4) vv[i4] = *(const u32x4*)(VB + (size_t)(tok0 + (long)d * (kp0 + 8 * i4 + vkey)) * 768 + coff + vch * 8);
        const bf16_t* krow = KB + (size_t)(tok0 + (long)d * (kp0 + r32)) * 768 + coff;
        f32x16 s = {};
#pragma unroll
        for (int ks = 0; ks < 4; ++ks) { const bf16x8 kf = *(const bf16x8*)(krow + 16 * ks + 8 * hi); s = __builtin_amdgcn_mfma_f32_32x32x16_bf16(kf, qf[ks], s, 0, 0, 0); }
        float mx = -1e30f;
#pragma unroll
        for (int rr = 0; rr < 16; ++rr) { const int kk = (rr & 3) + 8 * (rr >> 2) + 4 * hi;
            if ((kt == 0 && kk < r32) || (kt == 4 && kk > r32)) s[rr] = -1e30f;
            mx = fmaxf(mx, s[rr]); }
        mx = fmaxf(mx, __shfl_xor(mx, 32));
        const float m_new = fmaxf(m_run, mx), alpha = __builtin_amdgcn_exp2f(m_run - m_new);
        float rsum = 0.f;
#pragma unroll
        for (int rr = 0; rr < 16; ++rr) { s[rr] = __builtin_amdgcn_exp2f(s[rr] - m_new); rsum += s[rr]; }
        rsum += __shfl_xor(rsum, 32);
        l_run = l_run * alpha + rsum; m_run = m_new;
#pragma unroll
        for (int rr = 0; rr < 16; ++rr) { o0[rr] *= alpha; o1[rr] *= alpha; }
        bf16x8 pf[2];
#pragma unroll
        for (int s2 = 0; s2 < 2; ++s2) { u32x4 w; w.x = cvtpk(s[8 * s2], s[8 * s2 + 1]); w.y = cvtpk(s[8 * s2 + 2], s[8 * s2 + 3]); w.z = cvtpk(s[8 * s2 + 4], s[8 * s2 + 5]); w.w = cvtpk(s[8 * s2 + 6], s[8 * s2 + 7]); pf[s2] = __builtin_bit_cast(bf16x8, w); }
#pragma unroll
        for (int i4 = 0; i4 < 4; ++i4) *(LAS u32x4*)(wl + (8 * i4 + vkey) * VROWB + vch * 16) = vv[i4];
        LDS_WAIT(); asm volatile("" ::: "memory");
#pragma unroll
        for (int s2 = 0; s2 < 2; ++s2) {
#pragma unroll
            for (int dt = 0; dt < 2; ++dt) {
                const int kb = 16 * s2 + 4 * hi + trq;
                const s16x4 lo = vtr(wl + kb * VROWB + (32 * dt + trc) * 2), hi4 = vtr(wl + (kb + 8) * VROWB + (32 * dt + trc) * 2);
                const bf16x8 vf = (bf16x8){lo[0], lo[1], lo[2], lo[3], hi4[0], hi4[1], hi4[2], hi4[3]};
                if (dt == 0) o0 = __builtin_amdgcn_mfma_f32_32x32x16_bf16(vf, pf[s2], o0, 0, 0, 0); else o1 = __builtin_amdgcn_mfma_f32_32x32x16_bf16(vf, pf[s2], o1, 0, 0, 0);
            }
        }
        LDS_WAIT(); asm volatile("" ::: "memory");
    }
    const float inv = 1.f / l_run;
    const size_t tok = (size_t)(tok0 + (long)d * (m0 + r32));
    bf16_t* orow = OG + ((size_t)g * M + tok) * 256 + h * 64;
#pragma unroll
    for (int rq = 0; rq < 4; ++rq) {
        u32x2 w0, w1; w0.x = cvtpk(o0[4 * rq] * inv, o0[4 * rq + 1] * inv); w0.y = cvtpk(o0[4 * rq + 2] * inv, o0[4 * rq + 3] * inv);
        w1.x = cvtpk(o1[4 * rq] * inv, o1[4 * rq + 1] * inv); w1.y = cvtpk(o1[4 * rq + 2] * inv, o1[4 * rq + 3] * inv);
        *(u32x2*)(orow + 8 * rq + 4 * hi) = w0; *(u32x2*)(orow + 32 + 8 * rq + 4 * hi) = w1;
    }
    if (hi == 0) LSE[((size_t)g * M + tok) * 4 + h] = m_run + __builtin_amdgcn_logf(l_run);
}

template <int CTRL> __device__ __forceinline__ float dpp_add(float v) { return v + __int_as_float(__builtin_amdgcn_update_dpp(0, __float_as_int(v), CTRL, 0xf, 0xf, true)); }
__device__ __forceinline__ float row16_sum(float v) { v = dpp_add<0xB1>(v); v = dpp_add<0x4E>(v); v = dpp_add<0x141>(v); v = dpp_add<0x140>(v); return v; }
__device__ __forceinline__ void attn_sample_task(const bf16_t* QB, const float* cache, const float* knew, bf16_t* OG, float* LSE, int n, int g, int l, int lane) {
    const int d = 1 << (2 * g), wb = 128 << (2 * g), row = MP + n * NSL + l;
    const u32x2 qw = *(const u32x2*)(QB + (size_t)row * 768 + g * 256 + lane * 4);
    const f32x4 q = {bflo(qw.x), bfhi(qw.x), bflo(qw.y), bfhi(qw.y)};
    const float* cb = cache + (size_t)n * wb * 512 + lane * 4;
    const float* nb = knew + (size_t)(n * NSL) * 512 + lane * 4;
    float m_run = -1e30f, l_run = 0.f; f32x4 o = {0.f, 0.f, 0.f, 0.f};
#pragma unroll 1
    for (int i0 = 0; i0 < 129; i0 += 8) {
        f32x4 kx[8], vx[8]; float sc[8];
#pragma unroll
        for (int j = 0; j < 8; ++j) { const int i = i0 + j; const int ridx = wb + l - d * (i < 129 ? i : 128);
            const float* p = ridx >= wb ? nb + (size_t)(ridx - wb) * 512 : cb + (size_t)ridx * 512;
            kx[j] = *(const f32x4*)p; vx[j] = *(const f32x4*)(p + 256); }
        float mx = -1e30f;
#pragma unroll
        for (int j = 0; j < 8; ++j) { float s = (q[0] * kx[j][0] + q[1] * kx[j][1]) + (q[2] * kx[j][2] + q[3] * kx[j][3]); s = row16_sum(s); if (i0 + j >= 129) s = -1e30f; sc[j] = s; mx = fmaxf(mx, s); }
        const float m_new = fmaxf(m_run, mx), alpha = __builtin_amdgcn_exp2f(m_run - m_new);
        l_run *= alpha; o = o * alpha; m_run = m_new;
#pragma unroll
        for (int j = 0; j < 8; ++j) { const float p = __builtin_amdgcn_exp2f(sc[j] - m_new); l_run += p; o += p * vx[j]; }
    }
    const float inv = 1.f / l_run;
    u32x2 w; w.x = cvtpk(o[0] * inv, o[1] * inv); w.y = cvtpk(o[2] * inv, o[3] * inv);
    *(u32x2*)(OG + ((size_t)g * M + row) * 256 + lane * 4) = w;
    if ((lane & 15) == 0) LSE[((size_t)g * M + row) * 4 + (lane >> 4)] = m_run + __builtin_amdgcn_logf(l_run);
}

__device__ __forceinline__ void phase_attention(Frame& F) {
    KArgs ka = kargs(); unsigned char* ws = ka->ws;
    const bf16_t* QB = (const bf16_t*)(ws + WS_QB); const bf16_t* KB = (const bf16_t*)(ws + WS_KB); const bf16_t* VB = (const bf16_t*)(ws + WS_VB);
    bf16_t* OG = (bf16_t*)(ws + WS_OG); float* LSE = (float*)(ws + WS_LSE);
    LAS unsigned char* wl = F.lds + F.wave * 16384;
    constexpr int N_S = NSB * 3, N_P = 768;
    for (int U = blockIdx.x; U < N_S + N_P; U += F.G) {
        if (U < N_S) { const int n = U / 3, g = U % 3;
            const float* cache = g == 0 ? ka->in[4] : g == 1 ? ka->in[5] : ka->in[6]; const float* knew = ka->out + (g == 0 ? O_KVS0 : g == 1 ? O_KVS1 : O_KVS2);
            attn_sample_task(QB, cache, knew, OG, LSE, n, g, F.wave, F.lane);
        } else { const int V = U - N_S, g = V >> 8, rem = V & 255, b = rem >> 7, rem2 = rem & 127, h = rem2 & 3, rem3 = rem2 >> 2, d = 1 << (2 * g), r = rem3 % d, qb = rem3 / d;
            attn_prompt_task(QB, KB, VB, OG, LSE, b, g, r, h, qb * 8 + F.wave, wl, F.lane);
        }
    }
}

__device__ __forceinline__ void phase_attn_merge(Frame& F) {
    KArgs ka = kargs(); unsigned char* ws = ka->ws; const bf16_t* OG = (const bf16_t*)(ws + WS_OG); const float* LSE = (const float*)(ws + WS_LSE); bf16_t* YA = (bf16_t*)(ws + WS_YATT);
    for (int row = F.gw; row < M; row += F.NGW) {
        const int h = F.lane >> 4;
        const float l0 = LSE[((size_t)0 * M + row) * 4 + h], l1 = LSE[((size_t)1 * M + row) * 4 + h], l2 = LSE[((size_t)2 * M + row) * 4 + h];
        const float mx = fmaxf(l0, fmaxf(l1, l2)); float w0 = __builtin_amdgcn_exp2f(l0 - mx), w1 = __builtin_amdgcn_exp2f(l1 - mx), w2 = __builtin_amdgcn_exp2f(l2 - mx);
        const float inv = 1.f / (w0 + w1 + w2); w0 *= inv; w1 *= inv; w2 *= inv;
        const u32x2 a = *(const u32x2*)(OG + ((size_t)0 * M + row) * 256 + F.lane * 4), b = *(const u32x2*)(OG + ((size_t)1 * M + row) * 256 + F.lane * 4), c = *(const u32x2*)(OG + ((size_t)2 * M + row) * 256 + F.lane * 4);
        u32x2 w; w.x = cvtpk(w0 * bflo(a.x) + w1 * bflo(b.x) + w2 * bflo(c.x), w0 * bfhi(a.x) + w1 * bfhi(b.x) + w2 * bfhi(c.x));
        w.y = cvtpk(w0 * bflo(a.y) + w1 * bflo(b.y) + w2 * bflo(c.y), w0 * bfhi(a.y) + w1 * bfhi(b.y) + w2 * bfhi(c.y));
        *(u32x2*)(YA + (size_t)row * 256 + F.lane * 4) = w;
    }
}

__device__ __forceinline__ void phase_ssm_scan(Frame& F) {
    KArgs ka = kargs(); unsigned char* ws = ka->ws; float* outp = ka->out; const float* SC = (const float*)(ws + WS_SC); const float* POW = (const float*)(ws + WS_POW); bf16_t* UGX = (bf16_t*)(ws + WS_UGX);
    for (int U = blockIdx.x; U < NB * NG; U += F.G) {
        const int b = U / NG, g = U % NG;
        const float* src = SC + ((size_t)g * NCR + b * NCH) * 128;
        LAS f32x4* L4 = (LAS f32x4*)F.lds;
        __syncthreads();
#pragma unroll 4
        for (int i = F.tid; i < NCH * 128 / 4; i += NWAVES * 64) L4[i] = ((const f32x4*)src)[i];
        __syncthreads();
        if (F.wave == 0) {
            const int p = F.lane; const float ar = POW[((size_t)(g * NP + p) * 33 + 32) * 2], ai = POW[((size_t)(g * NP + p) * 33 + 32) * 2 + 1];
            float hr = 0.f, hi = 0.f; const LAS f32x2* L2 = (const LAS f32x2*)F.lds;
#pragma unroll 8
            for (int c = 0; c < NCH; ++c) {
                *(unsigned*)(UGX + ((size_t)g * NCR + b * NCH + c) * UGP + 2 * p) = cvtpk(hr, hi);
                const f32x2 s = L2[c * 64 + p];
                const float nr = ar * hr - ai * hi + s.x, ni = ar * hi + ai * hr + s.y; hr = nr; hi = ni;
            }
            float* o = outp + O_SSMP + ((size_t)(b * NG + g) * NP + p) * 2; o[0] = hr; o[1] = hi;
        }
    }
    __syncthreads();
}

__device__ __forceinline__ void phase_final_norm(Frame& F) {
    KArgs ka = kargs(); const float* ssq4 = (const float*)(ka->ws + WS_SSQ) + 4 * (size_t)M; const float* gf = ka->in[33]; float* outp = ka->out;
    f32x4 gv[4];
#pragma unroll
    for (int j = 0; j < 4; ++j) gv[j] = ((const f32x4*)gf)[F.lane + 64 * j];
    for (int m = F.gw; m < M; m += F.NGW) {
        const float rs = rs_of(ssq4[m]); f32x4* xr = (f32x4*)(outp + (size_t)m * DM);
#pragma unroll
        for (int j = 0; j < 4; ++j) { f32x4 v = xr[F.lane + 64 * j]; xr[F.lane + 64 * j] = v * rs * gv[j]; }
    }
}

constexpr int N_PHASES = 14;
__global__ void __launch_bounds__(NWAVES * 64, 2) mk_fwd(Args args) {
    extern __shared__ __attribute__((aligned(16))) unsigned char lds_raw[];
    Frame F;
    F.lds = (LAS unsigned char*)lds_raw; F.tid = threadIdx.x; F.lane = F.tid & 63; F.wave = __builtin_amdgcn_readfirstlane(F.tid >> 6);
    F.G = gridDim.x; F.gw = blockIdx.x * NWAVES + F.wave; F.NGW = F.G * NWAVES;
    KArgs ka0 = kargs();
    unsigned char* ws = ka0->ws;
    volatile LAS unsigned* MISC = (volatile LAS unsigned*)(F.lds + MISC_OFF);
    for (int u = F.tid; u < (LDS_BYTES - LDSCTL_OFF) / 4; u += NWAVES * 64) ((LAS unsigned*)(F.lds + LDSCTL_OFF))[u] = 0u;
    __syncthreads();
    XcdBarrier bar; bar.bar = (unsigned*)(ws + WS_CTL) + CW_BAR; bar.x = 0; bar.st = nullptr;
    if (MK_N_LAUNCHES == 1) bar = xcd_barrier_post((unsigned*)(ws + WS_CTL) + CW_BAR, MISC + 8);
    const int lo = ka0->ph_lo, hi = ka0->ph_hi;
#define IN(k) (lo <= (k) && (k) < hi)
#define SEAM(k) do { if (IN(k) && IN((k) + 1)) xcd_barrier(bar); } while (0)
    LAS unsigned char* ring = F.lds;
    const int cid = (int)blockIdx.x;
#define WSB(off) ((const bf16_t*)(ka->ws + (off)))
#define RUN(CFG, Aoff, Boff, C0, EA) do { Epi<CFG::KIND> E_{EA}; pg8::gemm_phase<CFG>(ring, Aoff, Boff, F.G, cid, C0, E_); } while (0)
#define EA0() KArgs ka = kargs(); EpiArgs ea{}; ea.ws = ka->ws; ea.out = ka->out; ea.dskip = ka->in[21]

    if (IN(0)) { phase_prologue(F); } SEAM(0);
    if (IN(1)) {
        phase_build_ssm(F);
        EA0();
        { EpiArgs e = ea; e.ssq_i = 0; RUN(CfgGU, WSB(WS_XB), WSB(WS_W1GU), 0, e); }
        { RUN(CfgPP, WSB(WS_PB), WSB(WS_WPP), (M / 256 * 22) % 256, ea); }
    } SEAM(1);
    if (IN(2)) { EA0(); EpiArgs e = ea; e.base0 = ka->in[0]; e.base1 = ka->in[1]; e.ssq_o = 1; e.alpha = 0.5f; RUN(CfgDown, WSB(WS_HID), WSB(WS_W1D), 0, e); } SEAM(2);
    if (IN(3)) { EA0(); EpiArgs e = ea; e.ssq_i = 1; RUN(CfgWin, WSB(WS_XB), WSB(WS_WIN), 0, e); } SEAM(3);
    if (IN(4)) {
        EA0();
        RUN(CfgS1, WSB(WS_UGX) + 128, WSB(WS_WM), 0, ea);
        RUN(CfgSS, WSB(WS_USX), WSB(WS_BS), 64, ea);
        phase_attention(F);
    } SEAM(4);
    if (IN(5)) { phase_ssm_scan(F); phase_attn_merge(F); } SEAM(5);
    if (IN(6)) { EA0(); RUN(CfgS2, WSB(WS_UGX), WSB(WS_B2), 0, ea); } SEAM(6);
    if (IN(7)) { EA0(); RUN(CfgGLU, WSB(WS_YS), WSB(WS_WGLU), 0, ea); } SEAM(7);
    if (IN(8)) { EA0(); RUN(CfgM1, WSB(WS_YG), WSB(WS_WBS), 0, ea); } SEAM(8);
    if (IN(9)) { EA0(); RUN(CfgM2, WSB(WS_YATT), WSB(WS_WBA), 0, ea); } SEAM(9);
    if (IN(10)) { EA0(); EpiArgs e = ea; e.base0 = ka->out; e.base1 = ka->out + (size_t)MP * DM; e.ssq_o = 2; e.alpha = 1.0f; RUN(CfgOut, WSB(WS_MRG), WSB(WS_WOUT), 0, e); } SEAM(10);
    if (IN(11)) { EA0(); EpiArgs e = ea; e.ssq_i = 2; RUN(CfgGU, WSB(WS_XB), WSB(WS_W2GU), 0, e); } SEAM(11);
    if (IN(12)) { EA0(); EpiArgs e = ea; e.base0 = ka->out; e.base1 = ka->out + (size_t)MP * DM; e.ssq_o = 3; e.alpha = 0.5f; RUN(CfgDown, WSB(WS_HID), WSB(WS_W2D), 0, e); } SEAM(12);
    if (IN(13)) { EA0(); EpiArgs e = ea; e.base0 = ka->out; e.base1 = ka->out + (size_t)MP * DM; e.ssq_i = 3; e.ssq_o = 4; RUN(CfgPle, WSB(WS_XB), WSB(WS_WPG), 0, e); } SEAM(13);
    if (IN(14)) { phase_final_norm(F); }
#undef IN
#undef SEAM
}

extern "C" void kernel_launch(void* const* d_in, const int* in_sizes, int n_in, void* d_out, int out_size, void* d_ws, size_t ws_size, hipStream_t stream) {
    static int grid = 0;
    if (grid == 0) {
        if (n_in != 34 || out_size != (int)O_END || ws_size < WS_END) { fprintf(stderr, "kernel_launch: unexpected shapes (n_in %d, out %d, ws %zu)\n", n_in, out_size, ws_size); grid = -1; return; }
        int dev = 0, cus = 0, per_cu = 0;
        if (hipGetDevice(&dev) != hipSuccess || hipDeviceGetAttribute(&cus, hipDeviceAttributeMultiprocessorCount, dev) != hipSuccess) { grid = -1; return; }
        if (hipFuncSetAttribute((const void*)mk_fwd, hipFuncAttributeMaxDynamicSharedMemorySize, LDS_BYTES) != hipSuccess) { fprintf(stderr, "kernel_launch: hipFuncSetAttribute failed\n"); grid = -1; return; }
        if (hipOccupancyMaxActiveBlocksPerMultiprocessor(&per_cu, (const void*)mk_fwd, NWAVES * 64, LDS_BYTES) != hipSuccess || per_cu < 1) { fprintf(stderr, "kernel_launch: occupancy query says %d\n", per_cu); }
        (void)hipGetLastError();
        grid = cus;
    }
    if (grid < 0) return;
    (void)hipMemsetAsync((char*)d_ws + WS_CTL, 0, CTL_ZERO_BYTES, stream);
    Args a{};
    for (int i = 0; i < 34; ++i) a.in[i] = (const float*)d_in[i];
    a.out = (float*)d_out; a.ws = (unsigned char*)d_ws;
    if (MK_N_LAUNCHES == 1) { a.ph_lo = 0; a.ph_hi = N_PHASES + 1; hipLaunchKernelGGL(mk_fwd, dim3(grid), dim3(NWAVES * 64), LDS_BYTES, stream, a); }
    else for (int p = 0; p <= N_PHASES; ++p) { a.ph_lo = p; a.ph_hi = p + 1; hipLaunchKernelGGL(mk_fwd, dim3(grid), dim3(NWAVES * 64), LDS_BYTES, stream, a); }
}
```

```cpp
#include <hip/hip_runtime.h>
#include <cstdio>
#include <cstdint>

#ifndef MK_N_LAUNCHES
#define MK_N_LAUNCHES 1
#endif

#ifndef PROBE_DUP
#define PROBE_DUP 0
#endif
#define LAS __attribute__((address_space(3)))
#define GAS __attribute__((address_space(1)))
typedef unsigned short bf16_t;
typedef short bf16x8 __attribute__((ext_vector_type(8)));
typedef short s16x4 __attribute__((ext_vector_type(4)));
typedef float f32x4 __attribute__((ext_vector_type(4)));
typedef float f32x2 __attribute__((ext_vector_type(2)));
typedef float f32x16 __attribute__((ext_vector_type(16)));
typedef unsigned u32x4 __attribute__((ext_vector_type(4)));
typedef unsigned u32x2 __attribute__((ext_vector_type(2)));
typedef __bf16 bf16x2_t __attribute__((ext_vector_type(2)));

constexpr int DM = 1024, SEQ = 8192, NB = 2, MP = NB * SEQ, NSB = 128, NSL = 8, MS = NSB * NSL, M = MP + MS;
constexpr int DFF = 2816, DPLE = 256, DSSM = 512, NG = 32, NP = 64, DIN = 4864;
constexpr int KMRG = 768;
constexpr int TCH = 32, NCH = SEQ / TCH, NCR = NB * NCH;
constexpr int UGP = 128 + TCH * 16;
constexpr float EPS = 1e-6f, LOG2E = 1.4426950408889634f, QSCALE = 0.125f * 1.4426950408889634f;

constexpr size_t O_Y = 0, O_KVP0 = (size_t)M * DM, O_KVP1 = O_KVP0 + 131072, O_KVP2 = O_KVP1 + 524288, O_SSMP = O_KVP2 + 2097152,
                 O_KVS0 = O_SSMP + 8192, O_KVS1 = O_KVS0 + 524288, O_KVS2 = O_KVS1 + 524288, O_SSMS = O_KVS2 + 524288, O_END = O_SSMS + 524288;

constexpr size_t MiB = 1u << 20;
constexpr size_t WS_CTL = 0, CTL_ZERO_BYTES = 1 * MiB;
constexpr size_t WS_SSQ = 512 * 1024;
constexpr size_t WS_W1GU = 2 * MiB, WS_W1D = 14 * MiB, WS_WIN = 20 * MiB, WS_WGLU = 30 * MiB, WS_WBS = 31 * MiB, WS_WBA = 32 * MiB, WS_WOUT = 33 * MiB,
                 WS_W2GU = 36 * MiB, WS_W2D = 48 * MiB, WS_WPG = 54 * MiB, WS_WPP = 57 * MiB, WS_WM = 58 * MiB, WS_B2 = 67 * MiB, WS_BS = 88 * MiB,
                 WS_KTAB = 93 * MiB, WS_POW = 95 * MiB, WS_BBAR = 96 * MiB;
constexpr size_t WS_XB = 100 * MiB, WS_HID = 136 * MiB, WS_QB = 232 * MiB, WS_KB = 258 * MiB, WS_VB = 284 * MiB, WS_SA = 310 * MiB, WS_SB = 346 * MiB,
                 WS_UGX = 382 * MiB, WS_USX = 403 * MiB, WS_SC = 406 * MiB, WS_YS = 415 * MiB, WS_YGOLD = 433 * MiB, WS_OG = 451 * MiB, WS_LSE = 478 * MiB,
                 WS_YATTOLD = 480 * MiB, WS_YGA = 490 * MiB  , WS_MRG = 526 * MiB, WS_PP = 562 * MiB, WS_PB = 598 * MiB, WS_END = 608 * MiB;
static_assert(WS_W1GU + (size_t)5632 * 1024 * 2 <= WS_W1D && WS_W1D + (size_t)1024 * 2816 * 2 <= WS_WIN && WS_WIN + (size_t)DIN * 1024 * 2 <= WS_WGLU, "ws map 1");
static_assert(WS_WM + (size_t)NG * 256 * 512 * 2 <= WS_B2 && WS_B2 + (size_t)NG * 512 * UGP * 2 <= WS_BS && WS_BS + (size_t)NG * 256 * 256 * 2 <= WS_KTAB, "ws map 2");
static_assert(WS_XB + (size_t)M * DM * 2 <= WS_HID && WS_HID + (size_t)M * DFF * 2 <= WS_QB && WS_QB + (size_t)M * 768 * 2 <= WS_KB && WS_SA + (size_t)M * DM * 2 <= WS_SB, "ws map 3");
static_assert(WS_UGX + (size_t)NG * NCR * UGP * 2 <= WS_USX && WS_USX + (size_t)(NG + 1) * 128 * 256 * 2 <= WS_SC && WS_SC + (size_t)NG * NCR * 128 * 4 <= WS_YS, "ws map 4");
static_assert(WS_YS + (size_t)M * 512 * 2 <= WS_YGOLD && WS_OG + (size_t)3 * M * 256 * 2 <= WS_LSE && WS_LSE + (size_t)3 * M * 4 * 4 <= WS_YATTOLD && WS_YGA + (size_t)M * 768 * 2 <= WS_MRG, "ws map 5");
static_assert(WS_PB + (size_t)M * 256 * 2 <= WS_END && 5 * (size_t)M * 4 + WS_SSQ <= CTL_ZERO_BYTES, "ws map 6");
constexpr int CW_BAR = 4096;

constexpr int RING_BYTES = 131072, LDSCTL_OFF = RING_BYTES, MISC_OFF = LDSCTL_OFF + 320, LDS_BYTES = 147456;
constexpr int NWAVES = 8;

__device__ __forceinline__ unsigned cvtpk(float lo, float hi) { f32x2 v = {lo, hi}; bf16x2_t b = __builtin_convertvector(v, bf16x2_t); return __builtin_bit_cast(unsigned, b); }
__device__ __forceinline__ float bflo(unsigned w) { return __uint_as_float(w << 16); }
__device__ __forceinline__ float bfhi(unsigned w) { return __uint_as_float(w & 0xffff0000u); }
__device__ __forceinline__ u32x4 pack8(f32x4 a, f32x4 b) { u32x4 w; w.x = cvtpk(a[0], a[1]); w.y = cvtpk(a[2], a[3]); w.z = cvtpk(b[0], b[1]); w.w = cvtpk(b[2], b[3]); return w; }
__device__ __forceinline__ void unpack8(u32x4 w, f32x4& a, f32x4& b) { a = (f32x4){bflo(w.x), bfhi(w.x), bflo(w.y), bfhi(w.y)}; b = (f32x4){bflo(w.z), bfhi(w.z), bflo(w.w), bfhi(w.w)}; }
__device__ __forceinline__ float sigmoidf_(float x) { return __builtin_amdgcn_rcpf(1.f + __builtin_amdgcn_exp2f(-x * LOG2E)); }
__device__ __forceinline__ f32x4 sigmoid4(f32x4 v) { return (f32x4){sigmoidf_(v[0]), sigmoidf_(v[1]), sigmoidf_(v[2]), sigmoidf_(v[3])}; }
__device__ __forceinline__ float gelu_tanh(float y) { const float z2 = 1.5957691216057308f * (y + 0.044715f * y * y * y); return y * sigmoidf_(z2); }
__device__ __forceinline__ f32x4 gelu4(f32x4 v) { return (f32x4){gelu_tanh(v[0]), gelu_tanh(v[1]), gelu_tanh(v[2]), gelu_tanh(v[3])}; }
__device__ __forceinline__ float rs_of(float ssq) { return __builtin_amdgcn_rsqf(ssq * (1.f / DM) + EPS); }
#define LDS_WAIT() asm volatile("s_waitcnt lgkmcnt(0)" ::: "memory")
#define VM_WAIT() asm volatile("s_waitcnt vmcnt(0)" ::: "memory")

namespace pg8 {
constexpr int BM = 256, BK = 64, HALF = 128, HTB = HALF * BK * 2, NXCD = 8, WGM = 8;
__device__ __forceinline__ int lds_byte(int r, int c) { const int st = (r >> 4) * 2 + (c >> 5), rr = r & 15, cc = c & 31, ob = rr * 64 + cc * 2; return st * 1024 + (ob ^ (((ob >> 9) & 1) << 5)); }
__device__ __forceinline__ void stage_rc(int b, int& R, int& C) { const int st = b / 1024, sb = b % 1024, swz = sb ^ (((sb >> 9) & 1) << 5); R = (st >> 1) * 16 + swz / 64; C = (st & 1) * 32 + (swz % 64) / 2; }
__device__ __forceinline__ int perm32(int rho) { const int n = rho >> 4, i = rho & 15; return 8 * (i >> 2) + 4 * n + (i & 3); }

struct Unit { int pm, pn, g, part; };
template <int nM, int nN, int nG, int UPC = 0, bool DUAL = false> struct Order {
    static constexpr int nwg = nM * nN * nG;
    int G, c;
    __device__ __forceinline__ void init(int G_, int c_, int c0) { G = G_; c = (c_ - c0 % G_ + G_) % G_; }
    __device__ __forceinline__ bool next(int i, Unit& u) const {
        u.part = 0; if constexpr (DUAL) { u.part = i & 1; i >>= 1; }
        long L = (long)i * G + c; if constexpr (UPC > 0) { if (i >= UPC) return false; L = (long)c * UPC + i; }
        if (L >= nwg) return false;
        int wgid = (int)L;
        if constexpr (nG == 1) {
            { constexpr int q = nwg / NXCD, r = nwg % NXCD; const int xcd = wgid % NXCD, off = wgid / NXCD; wgid = (xcd < r ? xcd * (q + 1) : r * (q + 1) + (xcd - r) * q) + off; }
            constexpr int nig = WGM * nN; const int gid = wgid / nig, fm = gid * WGM, gsz = (nM - fm) < WGM ? (nM - fm) : WGM;
            u.pm = fm + ((wgid % nig) % gsz); u.pn = (wgid % nig) / gsz; u.g = 0;
        } else { u.g = wgid / (nM * nN); const int r = wgid % (nM * nN); u.pm = r / nN; u.pn = r % nN; }
        return true;
    }
};

template <class C, class Epi>
__device__ __forceinline__ void gemm_phase(LAS unsigned char* lds, const bf16_t* gA, const bf16_t* gBt, int Gsz, int cu, int c0, const Epi& E) {
    int tid = threadIdx.x; asm volatile("" : "+v"(tid));
    const int wid = __builtin_amdgcn_readfirstlane(tid >> 6), lane = tid & 63, wr = wid >> 2, wc = wid & 3, fr = lane & 15, fq = lane >> 4;
    constexpr int nt = C::KK / BK;
    struct { const bf16_t* A; const bf16_t* Bt; } g{gA, gBt};
    Order<C::NM, C::NN, C::NGRP, C::UPC, (C::MIDT > 0)> S; S.init(Gsz, cu, c0);
    unsigned voffA[2], voffB[2];
#pragma unroll
    for (int i = 0; i < 2; ++i) { int R, Cc; stage_rc(tid * 16 + i * 8192, R, Cc); const int Rb = (R & ~31) + perm32(R & 31);
        voffA[i] = (unsigned)(R * C::LDA + Cc) * 2u; voffB[i] = (unsigned)(Rb * C::LDB + Cc) * 2u; }
    constexpr size_t kstep = (size_t)(BK * 2);
    constexpr size_t hstepA = (size_t)HALF * C::LDA * 2, hstepB = (size_t)HALF * C::LDB * 2;
    const unsigned ldsw = (unsigned)wid * 1024u;
    const int aoff = lds_byte(wr * 64 + fr, fq * 8), boff = lds_byte(wc * 32 + fr, fq * 8);
#define PG8_SA(b, h) (((b) * 2 + (h)) * HTB)
#define PG8_SB(b, h) ((4 + (b) * 2 + (h)) * HTB)
#define PG8_STAGE(bufoff, gbase, voff) do { _Pragma("unroll") for (int _i = 0; _i < 2; ++_i) \
        __builtin_amdgcn_global_load_lds((const unsigned*)((const char*)(gbase) + (voff)[_i]), (LAS unsigned*)(lds + (bufoff) + ldsw + _i * 8192), 16, 0, 0); } while (0)
#define PG8_LDA(dst, b, h) do { _Pragma("unroll") for (int m = 0; m < 4; ++m) _Pragma("unroll") for (int k = 0; k < 2; ++k) dst[m][k] = *(const LAS bf16x8*)(lds + PG8_SA(b, h) + aoff + m * 2048 + k * 1024); } while (0)
#define PG8_LDB(dst, b, h) do { _Pragma("unroll") for (int n = 0; n < 2; ++n) _Pragma("unroll") for (int k = 0; k < 2; ++k) dst[n][k] = *(const LAS bf16x8*)(lds + PG8_SB(b, h) + boff + n * 2048 + k * 1024); } while (0)
#define PG8_MMA(ai, bj, At, Bt) do { __builtin_amdgcn_s_setprio(1); _Pragma("unroll") for (int m = 0; m < 4; ++m) _Pragma("unroll") for (int n = 0; n < 2; ++n) _Pragma("unroll") for (int k = 0; k < 2; ++k) \
        acc[ai][bj][m][n] = __builtin_amdgcn_mfma_f32_16x16x32_bf16(Bt[n][k], At[m][k], acc[ai][bj][m][n], 0, 0, 0); __builtin_amdgcn_s_setprio(0); } while (0)
#define PG8_WAIT_V(n) asm volatile("s_waitcnt vmcnt(" #n ")" ::: "memory")
#define PG8_WAIT_L(n) asm volatile("s_waitcnt lgkmcnt(" #n ")" ::: "memory")
#define PG8_BAR __builtin_amdgcn_s_barrier()
#define PG8_SCHED __builtin_amdgcn_sched_barrier(0)
    Unit cur, nxt; int ui = 0;
    if (!S.next(0, cur)) return;
    f32x4 acc[2][2][4][2];
#pragma unroll
    for (int a = 0; a < 2; ++a)
#pragma unroll
        for (int b = 0; b < 2; ++b)
#pragma unroll
            for (int m = 0; m < 4; ++m)
#pragma unroll
                for (int n = 0; n < 2; ++n) acc[a][b][m][n] = (f32x4){0.f, 0.f, 0.f, 0.f};
    bf16x8 At[4][2], B0[2][2], B1[2][2];
    const char* cA = (const char*)(g.A + (size_t)cur.g * C::GSA) + (size_t)cur.pm * 2 * hstepA; const char* cB = (const char*)(g.Bt + (size_t)cur.g * C::GSB) + (size_t)cur.pn * 2 * hstepB;
    PG8_STAGE(PG8_SB(0, 0), cB, voffB); PG8_STAGE(PG8_SB(0, 1), cB + hstepB, voffB); PG8_STAGE(PG8_SA(0, 0), cA, voffA); PG8_STAGE(PG8_SA(0, 1), cA + hstepA, voffA);
    if (wr == 1) PG8_BAR;
    PG8_WAIT_V(2); PG8_BAR;
    PG8_STAGE(PG8_SB(1, 0), cB + kstep, voffB); PG8_STAGE(PG8_SA(1, 0), cA + kstep, voffA); PG8_STAGE(PG8_SB(1, 1), cB + hstepB + kstep, voffB);
    PG8_WAIT_V(6); PG8_BAR;
    for (;;) {
        const bool has_next = S.next(ui + 1, nxt);
        const size_t poff = (C::MIDT > 0 && has_next && nxt.part) ? (size_t)C::MIDT * kstep : 0;
        const char* nA = has_next ? (const char*)(g.A + (size_t)nxt.g * C::GSA) + (size_t)nxt.pm * 2 * hstepA + poff : cA;
        const char* nB = has_next ? (const char*)(g.Bt + (size_t)nxt.g * C::GSB) + (size_t)nxt.pn * 2 * hstepB + poff : cB;
        const int ntc = C::MIDT > 0 ? (cur.part ? nt - C::MIDT : C::MIDT) : nt;
#pragma unroll 1
        for (int t = 0; t < ntc; t += 2) {
            const bool last = (t == ntc - 2);
            const char* a1 = cA + (size_t)(t + 1) * kstep;
            const char* a2 = last ? nA : cA + (size_t)(t + 2) * kstep; const char* b2 = last ? nB : cB + (size_t)(t + 2) * kstep;
            const char* a3 = a2 + kstep; const char* b3 = b2 + kstep;
            PG8_LDB(B0, 0, 0); PG8_LDB(B1, 0, 1); PG8_SCHED; PG8_LDA(At, 0, 0); PG8_STAGE(PG8_SA(1, 1), a1 + hstepA, voffA);
            PG8_WAIT_V(8); PG8_WAIT_L(0); PG8_BAR; PG8_MMA(0, 0, At, B0); PG8_MMA(0, 1, At, B1); PG8_BAR; PG8_SCHED;
            PG8_LDA(At, 0, 1); PG8_STAGE(PG8_SB(0, 0), b2, voffB); PG8_STAGE(PG8_SB(0, 1), b2 + hstepB, voffB); PG8_STAGE(PG8_SA(0, 0), a2, voffA);
            PG8_WAIT_V(8); PG8_WAIT_L(0); PG8_BAR; PG8_MMA(1, 0, At, B0); PG8_MMA(1, 1, At, B1); PG8_BAR; PG8_SCHED;
            PG8_LDB(B0, 1, 0); PG8_LDB(B1, 1, 1); PG8_SCHED; PG8_LDA(At, 1, 0); PG8_STAGE(PG8_SA(0, 1), a2 + hstepA, voffA);
            PG8_WAIT_V(8); PG8_WAIT_L(0); PG8_BAR; PG8_MMA(0, 0, At, B0); PG8_MMA(0, 1, At, B1); PG8_BAR; PG8_SCHED;
            PG8_LDA(At, 1, 1); PG8_STAGE(PG8_SB(1, 0), b3, voffB); PG8_STAGE(PG8_SB(1, 1), b3 + hstepB, voffB); PG8_STAGE(PG8_SA(1, 0), a3, voffA);
            PG8_WAIT_V(8); PG8_WAIT_L(0); PG8_BAR; PG8_MMA(1, 0, At, B0); PG8_MMA(1, 1, At, B1); PG8_BAR; PG8_SCHED;
        }
        if (wr == 0) PG8_BAR;
        const bool midp = C::MIDT > 0 && cur.part == 0;
        if (midp) E.mid(acc, cur, wr, wc, fr, fq); else E(acc, cur, wr, wc, fr, fq);
        if (!has_next) break;
        if (!midp) {
#pragma unroll
        for (int a = 0; a < 2; ++a)
#pragma unroll
            for (int b = 0; b < 2; ++b)
#pragma unroll
                for (int m = 0; m < 4; ++m)
#pragma unroll
                    for (int n = 0; n < 2; ++n) acc[a][b][m][n] = (f32x4){0.f, 0.f, 0.f, 0.f};
        }
        cur = nxt; cA = nA; cB = nB; ++ui;
        if (wr == 1) PG8_BAR;
    }
    PG8_WAIT_V(0);
    PG8_BAR;
#undef PG8_SA
#undef PG8_SB
#undef PG8_STAGE
#undef PG8_LDA
#undef PG8_LDB
#undef PG8_MMA
#undef PG8_WAIT_V
#undef PG8_WAIT_L
#undef PG8_BAR
#undef PG8_SCHED
}
}


struct Args { const float* in[34]; float* out; unsigned char* ws; int ph_lo, ph_hi; };

struct Frame {
    LAS unsigned char* lds; int tid, lane, wave, G, gw, NGW;
};
typedef const float* cfp_t;
typedef const __attribute__((address_space(4))) Args* KArgs;
__device__ __forceinline__ KArgs kargs() { KArgs p = (KArgs)__builtin_amdgcn_kernarg_segment_ptr(); asm volatile("" : "+s"(p)); return p; }
__device__ __forceinline__ float wave_sum(float v) {
#pragma unroll
    for (int o = 1; o < 64; o <<= 1) v += __shfl_xor(v, o);
    return v;
}

enum { EK_SWIGLU = 1, EK_RESID, EK_PLE, EK_WIN, EK_S1, EK_S2, EK_SS, EK_GLU, EK_MRG, EK_PP };
struct EpiArgs {
    unsigned char* ws; float* out;
    const float* base0; const float* base1;
    const float* dskip;
    int ssq_i, ssq_o;
    float alpha;
};
#define WSP(T, off) ((T*)(a.ws + (off)))
template <int KIND> __device__ __forceinline__ float resid8(const EpiArgs& a, int row, int col, f32x4 x0, f32x4 x1) {
    const float* bp = row < MP ? a.base0 + (size_t)row * DM : a.base1 + (size_t)(row - MP) * DM;
    const f32x4 b0 = *(const f32x4*)(bp + col), b1 = *(const f32x4*)(bp + col + 4);
    f32x4 v0, v1;
    if constexpr (KIND == EK_PLE) { const float rs = rs_of(WSP(const float, WS_SSQ)[(size_t)a.ssq_i * M + row]); f32x4 p0, p1; unpack8(*(const u32x4*)(WSP(const bf16_t, WS_PP) + (size_t)row * DM + col), p0, p1);
        v0 = b0 + sigmoid4(x0 * rs) * p0; v1 = b1 + sigmoid4(x1 * rs) * p1; }
    else { v0 = b0 + a.alpha * x0; v1 = b1 + a.alpha * x1; }
    *(f32x4*)(a.out + (size_t)row * DM + col) = v0; *(f32x4*)(a.out + (size_t)row * DM + col + 4) = v1;
    if constexpr (KIND == EK_RESID) *(u32x4*)(WSP(bf16_t, WS_XB) + (size_t)row * DM + col) = pack8(v0, v1);
    return (v0[0] * v0[0] + v0[1] * v0[1]) + (v0[2] * v0[2] + v0[3] * v0[3]) + (v1[0] * v1[0] + v1[1] * v1[1]) + (v1[2] * v1[2] + v1[3] * v1[3]);
}
template <int KIND> struct Epi {
    EpiArgs a;
    __device__ __forceinline__ void mid(f32x4 (&acc)[2][2][4][2], const pg8::Unit& u, int wr, int wc, int fr, int fq) const {
        const int c8t = wc * 32 + 8 * fq;
#pragma unroll
        for (int ai = 0; ai < 2; ++ai)
#pragma unroll
            for (int m = 0; m < 4; ++m) { const int row = u.pm * 256 + ai * 128 + wr * 64 + m * 16 + fr;
#pragma unroll
                for (int bj = 0; bj < 2; ++bj) { const int col = u.pn * 256 + bj * 128 + c8t;
                    f32x4 a0, a1, b0, b1; unpack8(*(const u32x4*)(WSP(const bf16_t, WS_SA) + (size_t)row * DM + col), a0, a1); unpack8(*(const u32x4*)(WSP(const bf16_t, WS_SB) + (size_t)row * DM + col), b0, b1);
#pragma unroll
                    for (int e = 0; e < 4; ++e) { acc[ai][bj][m][0][e] *= a0[e] * __builtin_amdgcn_rcpf(b0[e]); acc[ai][bj][m][1][e] *= a1[e] * __builtin_amdgcn_rcpf(b1[e]); } }
                asm volatile("" ::: "memory"); }
    }
    __device__ __forceinline__ void operator()(f32x4 (&acc)[2][2][4][2], const pg8::Unit& u, int wr, int wc, int fr, int fq) const {
        const int c8t = wc * 32 + 8 * fq;
#pragma unroll
        for (int ai = 0; ai < 2; ++ai)
#pragma unroll
            for (int m = 0; m < 4; ++m) {
                const int row = u.pm * 256 + ai * 128 + wr * 64 + m * 16 + fr;
                if constexpr (KIND == EK_SWIGLU) {
                    const float rs = rs_of(WSP(const float, WS_SSQ)[(size_t)a.ssq_i * M + row]);
                    const f32x4 g0 = acc[ai][0][m][0] * rs, g1 = acc[ai][0][m][1] * rs, u0 = acc[ai][1][m][0] * rs, u1 = acc[ai][1][m][1] * rs;
                    const f32x4 h0 = g0 * sigmoid4(g0) * u0, h1 = g1 * sigmoid4(g1) * u1;
                    *(u32x4*)(WSP(bf16_t, WS_HID) + (size_t)row * DFF + u.pn * 128 + c8t) = pack8(h0, h1);
                } else if constexpr (KIND == EK_RESID || KIND == EK_PLE) {
                    float sq = 0.f;
#pragma unroll
                    for (int bj = 0; bj < 2; ++bj) sq += resid8<KIND>(a, row, u.pn * 256 + bj * 128 + c8t, acc[ai][bj][m][0], acc[ai][bj][m][1]);
                    sq += __shfl_xor(sq, 16); sq += __shfl_xor(sq, 32);
                    if (fq == 0) atomicAdd(WSP(float, WS_SSQ) + (size_t)a.ssq_o * M + row, sq);
                } else if constexpr (KIND == EK_WIN) {
                    const float rs = rs_of(WSP(const float, WS_SSQ)[(size_t)a.ssq_i * M + row]);
                    const int pn = u.pn;
#pragma unroll
                    for (int bj = 0; bj < 2; ++bj) {
                        const int c8 = bj * 128 + c8t;
                        f32x4 v0 = acc[ai][bj][m][0] * rs, v1 = acc[ai][bj][m][1] * rs;
                        if (pn < 2) {
                            const int col = pn * 256 + c8, grp = col >> 4, ch0 = col & 15;
                            bf16_t* dst = row < MP ? WSP(bf16_t, WS_UGX) + ((size_t)grp * NCR + (row >> 5)) * UGP + 128 + (row & 31) * 16 + ch0
                                                   : WSP(bf16_t, WS_USX) + ((size_t)grp * 128 + ((row - MP) >> 3)) * 256 + 128 + ((row - MP) & 7) * 16 + ch0;
                            *(u32x4*)dst = pack8(v0, v1);
                        } else if (pn < 5) {
                            *(u32x4*)(WSP(bf16_t, WS_QB) + (size_t)row * 768 + (pn - 2) * 256 + c8) = pack8(v0 * QSCALE, v1 * QSCALE);
                        } else if (pn < 11) {
                            const int kvsel = pn >= 8 ? 1 : 0, gq = (pn - 5) % 3, keep = 128 << (2 * gq);
                            *(u32x4*)(WSP(bf16_t, (kvsel ? WS_VB : WS_KB)) + (size_t)row * 768 + gq * 256 + c8) = pack8(v0, v1);
                            float* fo = nullptr;
                            if (row >= MP) fo = a.out + (gq == 0 ? O_KVS0 : gq == 1 ? O_KVS1 : O_KVS2) + ((size_t)(row - MP) * 2 + kvsel) * 256 + c8;
                            else { const int b = row >> 13, t = row & (SEQ - 1); if (t >= SEQ - keep) fo = a.out + (gq == 0 ? O_KVP0 : gq == 1 ? O_KVP1 : O_KVP2) + (((size_t)b * keep + (t - (SEQ - keep))) * 2 + kvsel) * 256 + c8; }
                            if (fo) { *(f32x4*)fo = v0; *(f32x4*)(fo + 4) = v1; }
                        } else {
                            *(u32x4*)(WSP(bf16_t, (pn < 15 ? WS_SA : WS_SB)) + (size_t)row * DM + ((pn - 11) & 3) * 256 + c8) = pack8(sigmoid4(v0), sigmoid4(v1));
                        }
                    }
                } else if constexpr (KIND == EK_S1) {
                    if (u.pn == 0) { float* d = WSP(float, WS_SC) + ((size_t)u.g * NCR + row) * 128 + c8t; *(f32x4*)d = acc[ai][0][m][0]; *(f32x4*)(d + 4) = acc[ai][0][m][1]; }
                } else if constexpr (KIND == EK_S2) {
#pragma unroll
                    for (int bj = 0; bj < 2; ++bj) {
                        const int col = u.pn * 256 + bj * 128 + c8t, t = col >> 4, ch0 = col & 15;
                        f32x4 u0, u1; unpack8(*(const u32x4*)(WSP(const bf16_t, WS_UGX) + ((size_t)u.g * NCR + row) * UGP + 128 + t * 16 + ch0), u0, u1);
                        const f32x4 d0 = *(const f32x4*)(a.dskip + u.g * 16 + ch0), d1 = *(const f32x4*)(a.dskip + u.g * 16 + ch0 + 4);
                        const f32x4 y0 = gelu4(acc[ai][bj][m][0] + d0 * u0), y1 = gelu4(acc[ai][bj][m][1] + d1 * u1);
                        *(u32x4*)(WSP(bf16_t, WS_YS) + ((size_t)row * TCH + t) * DSSM + u.g * 16 + ch0) = pack8(y0, y1);
                    }
                } else if constexpr (KIND == EK_SS) {
                    if (ai == 0) {
                        const int n = row;
                        { const int col = c8t, l = col >> 4, ch0 = col & 15;
                          f32x4 u0, u1; unpack8(*(const u32x4*)(WSP(const bf16_t, WS_USX) + ((size_t)u.g * 128 + n) * 256 + 128 + l * 16 + ch0), u0, u1);
                          const f32x4 d0 = *(const f32x4*)(a.dskip + u.g * 16 + ch0), d1 = *(const f32x4*)(a.dskip + u.g * 16 + ch0 + 4);
                          const f32x4 y0 = gelu4(acc[0][0][m][0] + d0 * u0), y1 = gelu4(acc[0][0][m][1] + d1 * u1);
                          *(u32x4*)(WSP(bf16_t, WS_YS) + ((size_t)(MP + n * 8 + l)) * DSSM + u.g * 16 + ch0) = pack8(y0, y1); }
                        { float* d = a.out + O_SSMS + ((size_t)n * NG + u.g) * 128 + c8t; *(f32x4*)d = acc[0][1][m][0]; *(f32x4*)(d + 4) = acc[0][1][m][1]; }
                    }
                } else if constexpr (KIND == EK_GLU) {
#pragma unroll
                    for (int bj = 0; bj < 2; ++bj) { const int col = u.pn * 256 + bj * 128 + c8t;
                        f32x4 y0, y1; unpack8(*(const u32x4*)(WSP(const bf16_t, WS_YS) + (size_t)row * DSSM + col), y0, y1);
                        *(u32x4*)(WSP(bf16_t, WS_YGA) + (size_t)row * KMRG + col) = pack8(y0 * sigmoid4(acc[ai][bj][m][0]), y1 * sigmoid4(acc[ai][bj][m][1])); }
                } else if constexpr (KIND == EK_MRG) {
#pragma unroll
                    for (int bj = 0; bj < 2; ++bj) { const int col = u.pn * 256 + bj * 128 + c8t;
                        f32x4 s0, s1; unpack8(*(const u32x4*)(WSP(const bf16_t, WS_SB) + (size_t)row * DM + col), s0, s1);
                        *(u32x4*)(WSP(bf16_t, WS_MRG) + (size_t)row * DM + col) = pack8(s0 * acc[ai][bj][m][0], s1 * acc[ai][bj][m][1]); }
                } else if constexpr (KIND == EK_PP) {
#pragma unroll
                    for (int bj = 0; bj < 2; ++bj) { const int col = u.pn * 256 + bj * 128 + c8t;
                        *(u32x4*)(WSP(bf16_t, WS_PP) + (size_t)row * DM + col) = pack8(acc[ai][bj][m][0], acc[ai][bj][m][1]); }
                }
            }
    }
};


template <int KIND, int LDA, int LDB, int KK>
__device__ __forceinline__ void mini_gemm(Frame& F, const bf16_t* A, const bf16_t* Bt, int mu, const EpiArgs& a) {
    const int lane = F.lane, w = F.wave;
    const int r0 = MP + 64 * (mu >> 4), c0 = 64 * (mu & 15);
    f32x4 acc[4][4];
#pragma unroll
    for (int m = 0; m < 4; ++m)
#pragma unroll
        for (int n = 0; n < 4; ++n) acc[m][n] = (f32x4){0.f, 0.f, 0.f, 0.f};
    int kbeg, ksteps;
    if constexpr (KIND == EK_MRG) { if (w < 4) { kbeg = w * 128; ksteps = 4; } else { kbeg = DSSM + (w - 4) * 64; ksteps = 2; } }
    else { kbeg = w * (KK / 8); ksteps = KK / 8 / 32; }
    const bf16_t* ap = A + (size_t)(r0 + (lane & 15)) * LDA + kbeg + 8 * (lane >> 4);
    const bf16_t* bp = Bt + (size_t)(c0 + (lane & 15)) * LDB + kbeg + 8 * (lane >> 4);
#pragma unroll 2
    for (int s = 0; s < ksteps; ++s) {
        bf16x8 af[4], bfr[4];
#pragma unroll
        for (int m = 0; m < 4; ++m) af[m] = *(const bf16x8*)(ap + (size_t)16 * m * LDA + 32 * s);
#pragma unroll
        for (int n = 0; n < 4; ++n) bfr[n] = *(const bf16x8*)(bp + (size_t)16 * n * LDB + 32 * s);
#pragma unroll
        for (int m = 0; m < 4; ++m)
#pragma unroll
            for (int n = 0; n < 4; ++n) acc[m][n] = __builtin_amdgcn_mfma_f32_16x16x32_bf16(bfr[n], af[m], acc[m][n], 0, 0, 0);
    }
    __syncthreads();
    LAS float* P = (LAS float*)F.lds;
#pragma unroll
    for (int m = 0; m < 4; ++m)
#pragma unroll
        for (int n = 0; n < 4; ++n) { const int row = 16 * m + (lane & 15), chunk = 4 * n + (lane >> 4); *(LAS f32x4*)(P + w * 4096 + row * 64 + ((chunk ^ (row & 15)) << 2)) = acc[m][n]; }
    __syncthreads();
    const int row = F.tid >> 3, ch = 2 * (F.tid & 7);
    f32x4 x0 = {0.f, 0.f, 0.f, 0.f}, x1 = x0, y0 = x0, y1 = x0;
#pragma unroll
    for (int w2 = 0; w2 < 8; ++w2) { const f32x4 p0 = *(const LAS f32x4*)(P + w2 * 4096 + row * 64 + ((ch ^ (row & 15)) << 2)), p1 = *(const LAS f32x4*)(P + w2 * 4096 + row * 64 + (((ch + 1) ^ (row & 15)) << 2));
        if (KIND == EK_MRG && w2 >= 4) { y0 += p0; y1 += p1; } else { x0 += p0; x1 += p1; } }
    const int grow = r0 + row, gcol = c0 + 8 * (F.tid & 7);
    if constexpr (KIND == EK_MRG) {
        f32x4 a0, a1, b0, b1; unpack8(*(const u32x4*)(WSP(const bf16_t, WS_SA) + (size_t)grow * DM + gcol), a0, a1); unpack8(*(const u32x4*)(WSP(const bf16_t, WS_SB) + (size_t)grow * DM + gcol), b0, b1);
        *(u32x4*)(WSP(bf16_t, WS_MRG) + (size_t)grow * DM + gcol) = pack8(a0 * x0 + b0 * y0, a1 * x1 + b1 * y1);
    } else {
        float sq = resid8<KIND>(a, grow, gcol, x0, x1);
        sq += __shfl_xor(sq, 1); sq += __shfl_xor(sq, 2); sq += __shfl_xor(sq, 4);
        if ((F.tid & 7) == 0) atomicAdd(WSP(float, WS_SSQ) + (size_t)a.ssq_o * M + grow, sq);
    }
    __syncthreads();
}

#define DEFCFG(NAME, KIND_, LDA_, LDB_, KK_, NM_, NN_, NGRP_, GSA_, GSB_) struct NAME { static constexpr int KIND = KIND_, LDA = LDA_, LDB = LDB_, KK = KK_, NM = NM_, NN = NN_, NGRP = NGRP_, UPC = 0, MIDT = 0; static constexpr long GSA = GSA_, GSB = GSB_; }
DEFCFG(CfgGU,   EK_SWIGLU, DM,   DM,   DM,   M / 256, 22, 1, 0, 0);
DEFCFG(CfgPP,   EK_PP,     DPLE, DPLE, DPLE, M / 256, 4,  1, 0, 0);
DEFCFG(CfgDown, EK_RESID,  DFF,  DFF,  DFF,  MP / 256, 4, 1, 0, 0);
DEFCFG(CfgWin,  EK_WIN,    DM,   DM,   DM,   M / 256, 19, 1, 0, 0);
DEFCFG(CfgS1,   EK_S1,     UGP,  512,  512,  2, 1, NG, (long)NCR * UGP, 256L * 512);
DEFCFG(CfgSS,   EK_SS,     256,  256,  256,  1, 1, NG, 128L * 256, 256L * 256);
struct CfgS2 { static constexpr int KIND = EK_S2, LDA = UGP, LDB = UGP, KK = UGP, NM = 2, NN = 2, NGRP = NG, UPC = 2, MIDT = 0; static constexpr long GSA = (long)NCR * UGP, GSB = 512L * UGP; };
DEFCFG(CfgGLU,  EK_GLU,    DSSM, DSSM, DSSM, M / 256, 2,  1, 0, 0);
struct CfgMrg { static constexpr int KIND = EK_MRG, LDA = KMRG, LDB = KMRG, KK = KMRG, NM = MP / 256, NN = 4, NGRP = 1, UPC = 0, MIDT = 8; static constexpr long GSA = 0, GSB = 0; };
DEFCFG(CfgOut,  EK_RESID,  DM,   DM,   DM,   MP / 256, 4, 1, 0, 0);
DEFCFG(CfgPle,  EK_PLE,    DM,   DM,   DM,   MP / 256, 4, 1, 0, 0);

typedef GAS unsigned gu32;
#define RLX_AGENT __ATOMIC_RELAXED, __HIP_MEMORY_SCOPE_AGENT
#define XB_TMO      128
#define XB_XCNT(j)  (256  + 64 * (j))
#define XB_XSUB(j)  (1280 + 64 * (j))
#define XB_XGEN(j)  (2304 + 64 * (j))
#define XB_TOP      3328
#define XB_TOPGEN   3392
#define XCD_BAR_WORDS 3456
#define XB_SPIN_CAP (1u << 18)
__device__ __forceinline__ unsigned xb_ld(unsigned* p)              { return __hip_atomic_load(p, __ATOMIC_RELAXED, __HIP_MEMORY_SCOPE_AGENT); }
__device__ __forceinline__ unsigned xb_add(unsigned* p, unsigned v) { return __hip_atomic_fetch_add(p, v, __ATOMIC_RELAXED, __HIP_MEMORY_SCOPE_AGENT); }
__device__ __forceinline__ unsigned xb_xcc_id() { return (unsigned)__builtin_amdgcn_s_getreg((3 << 11) | 20) & 0xFu; }
#define XB_SPIN(cond, bar) do { unsigned _sp = 0; while (cond) { __builtin_amdgcn_s_sleep(1); \
    if ((++_sp & 255u) == 0u) { if (xb_ld(&(bar)[XB_TMO])) break; if (_sp > XB_SPIN_CAP) { atomicAdd(&(bar)[XB_TMO], 1u); break; } } } } while (0)
struct XcdBarrier { unsigned* bar; unsigned x; volatile LAS unsigned* st; };
__device__ __forceinline__ XcdBarrier xcd_barrier_post(unsigned* bar, volatile LAS unsigned* st) {
    XcdBarrier b; b.bar = bar; b.x = xb_xcc_id(); b.st = st;
    if (threadIdx.x == 0) (void)xb_add(&bar[XB_XCNT(b.x)], 1u);
    return b;
}
__device__ __forceinline__ void xcd_barrier_complete(unsigned* bar, unsigned x, unsigned& nloc, unsigned& nx) {
    const unsigned G = gridDim.x * gridDim.y * gridDim.z;
    unsigned sum, cnt, mine, sp = 0u;
    for (;;) {
        sum = 0u; cnt = 0u; mine = 0u;
#pragma unroll
        for (unsigned j = 0; j < 16; ++j) { const unsigned c = xb_ld(&bar[XB_XCNT(j)]); sum += c; cnt += (c > 0u) ? 1u : 0u; mine = (j == x) ? c : mine; }
        if (sum == G) break;
        __builtin_amdgcn_s_sleep(1);
        if ((++sp & 255u) == 0u) { if (xb_ld(&bar[XB_TMO])) break; if (sp > XB_SPIN_CAP) { atomicAdd(&bar[XB_TMO], 1u); break; } }
    }
    nloc = mine > 0u ? mine : 1u; nx = cnt > 0u ? cnt : 1u;
}
__device__ __forceinline__ void xcd_barrier(const XcdBarrier& b) {
    asm volatile("s_waitcnt vmcnt(0)" ::: "memory");
    __syncthreads();
    if (threadIdx.x == 0) {
        unsigned* bar = b.bar;
        __builtin_amdgcn_s_waitcnt(0);
        unsigned nloc = b.st[0], nx = b.st[1];
        if (nloc == 0u) { xcd_barrier_complete(bar, b.x, nloc, nx); b.st[0] = nloc; b.st[1] = nx; }
        const unsigned old = xb_add(&bar[XB_XSUB(b.x)], 1u);
        const unsigned gen = old / nloc;
        if (old + 1u == (gen + 1u) * nloc) {
            __builtin_amdgcn_fence(__ATOMIC_RELEASE, "agent");
            asm volatile("s_waitcnt vmcnt(0)" ::: "memory");
            const unsigned og = xb_add(&bar[XB_TOP], 1u);
            const unsigned tg = og / nx;
            if (og + 1u == (tg + 1u) * nx) xb_add(&bar[XB_TOPGEN], 1u);
            else XB_SPIN(xb_ld(&bar[XB_TOPGEN]) == tg, bar);
            __builtin_amdgcn_fence(__ATOMIC_ACQUIRE, "agent");
            xb_add(&bar[XB_XGEN(b.x)], 1u);
            asm volatile("s_waitcnt vmcnt(0)" ::: "memory");
        } else {
            XB_SPIN(xb_ld(&bar[XB_XGEN(b.x)]) == gen, bar);
            __builtin_amdgcn_fence(__ATOMIC_ACQUIRE, "agent");
            asm volatile("s_waitcnt vmcnt(0)" ::: "memory");
        }
    }
    __syncthreads();
}

__device__ __forceinline__ void p0_transpose_item(const float* W, int N, bf16_t* WT, int ldt, int k0, int n0, int dst_row0, const float* gk, LAS float* scr, int lane) {
    f32x4 v[16];
#pragma unroll
    for (int i = 0; i < 16; ++i) { const int kk = 4 * i + (lane >> 4); v[i] = *(const f32x4*)(W + (size_t)(k0 + kk) * N + n0 + 4 * (lane & 15)); }
    if (gk) {
#pragma unroll
        for (int i = 0; i < 16; ++i) v[i] = v[i] * gk[k0 + 4 * i + (lane >> 4)]; }
#pragma unroll
    for (int i = 0; i < 16; ++i) { const int kk = 4 * i + (lane >> 4); *(LAS f32x4*)(scr + kk * 64 + ((4 * (lane & 15)) ^ (((kk >> 3) & 7) << 2))) = v[i]; }
    LDS_WAIT(); asm volatile("" ::: "memory");
    const int c = lane & 7;
#pragma unroll
    for (int j = 0; j < 8; ++j) { const int n = (lane >> 3) + 8 * j; const LAS float* s = scr + (8 * c) * 64 + (n ^ (c << 2));
        u32x4 o; o.x = cvtpk(s[0 * 64], s[1 * 64]); o.y = cvtpk(s[2 * 64], s[3 * 64]); o.z = cvtpk(s[4 * 64], s[5 * 64]); o.w = cvtpk(s[6 * 64], s[7 * 64]);
        *(u32x4*)(WT + (size_t)(dst_row0 + n) * ldt + k0 + 8 * c) = o; }
    LDS_WAIT(); asm volatile("" ::: "memory");
}
struct WJob { const float* W; int K, N; bf16_t* WT; const float* gk; int mode; int ldt, koff; };
__device__ __forceinline__ void p0_wjob(const WJob& j, int item, LAS float* scr, int lane) {
    const int nblk = j.N / 64, kb = item / nblk, nb = item % nblk, n0 = 64 * nb;
    const int dst = j.mode == 0 ? n0 : (n0 / 128) * 256 + (n0 % 128) + (j.mode == 2 ? 128 : 0);
    p0_transpose_item(j.W, j.N, j.WT + j.koff, j.ldt, 64 * kb, n0, dst, j.gk, scr, lane);
}

__device__ __forceinline__ double dexp(double x) {
    const double k = __builtin_rint(x * 1.4426950408889634074), r = __builtin_fma(-k, 6.93147180369123816490e-01, x) - k * 1.90821492927058770002e-10;
    double p = 1.0 / 479001600.0;
    p = p * r + 1.0 / 39916800.0; p = p * r + 1.0 / 3628800.0; p = p * r + 1.0 / 362880.0; p = p * r + 1.0 / 40320.0; p = p * r + 1.0 / 5040.0; p = p * r + 1.0 / 720.0;
    p = p * r + 1.0 / 120.0; p = p * r + 1.0 / 24.0; p = p * r + 1.0 / 6.0; p = p * r + 0.5; p = p * r + 1.0; p = p * r + 1.0;
    return __builtin_ldexp(p, (int)k);
}
__device__ __forceinline__ void dsincos(double a, double& s, double& c) {
    const double k = __builtin_rint(a * 0.63661977236758134308);
    double r = __builtin_fma(-k, 1.57079632673412561417e+00, a); r = __builtin_fma(-k, 6.07710050650619224932e-11, r);
    const double z = r * r;
    double sp = -1.0 / 1307674368000.0; sp = sp * z + 1.0 / 6227020800.0; sp = sp * z - 1.0 / 39916800.0; sp = sp * z + 1.0 / 362880.0; sp = sp * z - 1.0 / 5040.0; sp = sp * z + 1.0 / 120.0; sp = sp * z - 1.0 / 6.0; sp = sp * z * r + r;
    double cp = 1.0 / 20922789888000.0; cp = cp * z - 1.0 / 87178291200.0; cp = cp * z + 1.0 / 479001600.0; cp = cp * z - 1.0 / 3628800.0; cp = cp * z + 1.0 / 40320.0; cp = cp * z - 1.0 / 720.0; cp = cp * z + 1.0 / 24.0; cp = cp * z - 0.5; cp = cp * z + 1.0;
    const int q = ((int)k) & 3;
    s = (q == 0) ? sp : (q == 1) ? cp : (q == 2) ? -sp : -cp;
    c = (q == 0) ? cp : (q == 1) ? -sp : (q == 2) ? -cp : sp;
}
__device__ __forceinline__ void cpow_d(double are, double aim, double dt, int n, double& pr, double& pi) {
    const double mag = dexp((double)n * are * dt); double s, c; dsincos((double)n * aim * dt, s, c); pr = mag * c; pi = mag * s;
}
__device__ __forceinline__ void ffac_d(double are, double aim, double dt, double& fr, double& fi) {
    double er, ei; cpow_d(are, aim, dt, 1, er, ei);
    const double nr = er - 1.0, ni = ei, den = are * are + aim * aim;
    fr = (nr * are + ni * aim) / den; fi = (ni * are - nr * aim) / den;
}

__device__ __forceinline__ void phase_prologue(Frame& F) {
    KArgs ka = kargs(); const __attribute__((address_space(4))) cfp_t* in = ka->in; unsigned char* ws = ka->ws;
    LAS float* scr = (LAS float*)(F.lds + F.wave * 16384);
    int it = F.gw;
#define DOJOB(W_, K_, N_, WT_, GK_, MODE_) DOJOB2(W_, K_, N_, WT_, GK_, MODE_, K_, 0)
#define DOJOB2(W_, K_, N_, WT_, GK_, MODE_, LDT_, KOFF_) do { const WJob jb{W_, K_, N_, (bf16_t*)(ws + WT_), GK_, MODE_, LDT_, KOFF_}; const int n_items = ((K_) / 64) * ((N_) / 64); \
        for (; it < n_items; it += F.NGW) p0_wjob(jb, it, scr, F.lane); it -= n_items; } while (0)
    DOJOB(in[9], DM, DFF, WS_W1GU, in[8], 1); DOJOB(in[10], DM, DFF, WS_W1GU, in[8], 2); DOJOB(in[11], DFF, DM, WS_W1D, nullptr, 0);
    DOJOB(in[13], DM, DIN, WS_WIN, in[12], 0); DOJOB(in[22], DSSM, DSSM, WS_WGLU, nullptr, 0); DOJOB2(in[23], DSSM, DM, WS_WBS, nullptr, 0, KMRG, 0);
    DOJOB2(in[24], 256, DM, WS_WBS, nullptr, 0, KMRG, DSSM); DOJOB(in[25], DM, DM, WS_WOUT, nullptr, 0);
    DOJOB(in[27], DM, DFF, WS_W2GU, in[26], 1); DOJOB(in[28], DM, DFF, WS_W2GU, in[26], 2); DOJOB(in[29], DFF, DM, WS_W2D, nullptr, 0);
    DOJOB(in[31], DM, DM, WS_WPG, in[30], 0); DOJOB(in[32], DPLE, DM, WS_WPP, nullptr, 0);
#undef DOJOB
#undef DOJOB2
    float* ssq0 = (float*)(ws + WS_SSQ);
    bf16_t* XB = (bf16_t*)(ws + WS_XB); bf16_t* PB = (bf16_t*)(ws + WS_PB);
    for (int m = F.gw; m < M; m += F.NGW) {
        const float* xr = m < MP ? in[0] + (size_t)m * DM : in[1] + (size_t)(m - MP) * DM;
        f32x4 v[4]; float s = 0.f;
#pragma unroll
        for (int j = 0; j < 4; ++j) { v[j] = ((const f32x4*)xr)[F.lane + 64 * j]; s += (v[j][0] * v[j][0] + v[j][1] * v[j][1]) + (v[j][2] * v[j][2] + v[j][3] * v[j][3]); }
        s = wave_sum(s);
        if (F.lane == 0) ssq0[m] = s;
#pragma unroll
        for (int j = 0; j < 4; ++j) { u32x2 w; w.x = cvtpk(v[j][0], v[j][1]); w.y = cvtpk(v[j][2], v[j][3]); ((u32x2*)(XB + (size_t)m * DM))[F.lane + 64 * j] = w; }
        const float* pr = m < MP ? in[2] + (size_t)m * DPLE : in[3] + (size_t)(m - MP) * DPLE;
        const f32x4 pv = ((const f32x4*)pr)[F.lane]; u32x2 w; w.x = cvtpk(pv[0], pv[1]); w.y = cvtpk(pv[2], pv[3]); ((u32x2*)(PB + (size_t)m * DPLE))[F.lane] = w;
    }
    bf16_t* USX = (bf16_t*)(ws + WS_USX);
    for (int i = F.gw; i < NSB * NG; i += F.NGW) { const int n = i / NG, g = i % NG;
        if (F.lane < 32) { const f32x4 v = ((const f32x4*)(in[7] + ((size_t)n * NG + g) * 128))[F.lane]; u32x2 w; w.x = cvtpk(v[0], v[1]); w.y = cvtpk(v[2], v[3]);
            ((u32x2*)(USX + ((size_t)g * 128 + n) * 256))[F.lane] = w; } }
    float* POW = (float*)(ws + WS_POW); float* BBAR = (float*)(ws + WS_BBAR);
    const int gt = F.gw * 64 + F.lane, NT = F.NGW * 64;
    for (int i = gt; i < NG * NP * 33 + NG * NP; i += NT) {
        if (i < NG * NP * 33) { const int gp = i / 33, n = i % 33, g = gp / NP;
            const double are = in[14][gp], aim = in[15][gp], dt = dexp((double)in[16][g]); double pr, pi; cpow_d(are, aim, dt, n, pr, pi);
            POW[(size_t)i * 2] = (float)pr; POW[(size_t)i * 2 + 1] = (float)pi;
        } else { const int gp = i - NG * NP * 33, g = gp / NP;
            const double are = in[14][gp], aim = in[15][gp], dt = dexp((double)in[16][g]); double fr, fi; ffac_d(are, aim, dt, fr, fi);
#pragma unroll 4
            for (int c = 0; c < 16; ++c) { const double br = in[17][gp * 16 + c], bi = in[18][gp * 16 + c];
                BBAR[((size_t)gp * 16 + c) * 2] = (float)(fr * br - fi * bi); BBAR[((size_t)gp * 16 + c) * 2 + 1] = (float)(fr * bi + fi * br); }
        }
    }
}

__device__ __forceinline__ void phase_build_ssm(Frame& F, int part) {
    KArgs ka = kargs(); const __attribute__((address_space(4))) cfp_t* in = ka->in; unsigned char* ws = ka->ws;
    const float* POW = (const float*)(ws + WS_POW); const float* BBAR = (const float*)(ws + WS_BBAR); float* KTAB = (float*)(ws + WS_KTAB);
    bf16_t* WM = (bf16_t*)(ws + WS_WM); bf16_t* B2 = (bf16_t*)(ws + WS_B2); bf16_t* BS = (bf16_t*)(ws + WS_BS);
    const int gt = F.gw * 64 + F.lane, NT = F.NGW * 64;
    if (part == 1) {
        for (int i = gt; i < NG * TCH * 256; i += NT) {
            const int g = i / (TCH * 256), tau = (i / 256) % TCH, c = (i >> 4) & 15, c2 = i & 15; float s = 0.f;
#pragma unroll 8
            for (int p = 0; p < NP; ++p) { const f32x2 pw = *(const f32x2*)(POW + ((size_t)(g * NP + p) * 33 + tau) * 2), bb = *(const f32x2*)(BBAR + ((size_t)(g * NP + p) * 16 + c2) * 2);
                const float zr = pw.x * bb.x - pw.y * bb.y, zi = pw.x * bb.y + pw.y * bb.x; s += in[19][(g * 16 + c) * NP + p] * zr - in[20][(g * 16 + c) * NP + p] * zi; }
            KTAB[i] = s;
        }
        constexpr int N_WM = NG * 256 * 64, N_B2 = NG * 512 * 16, N_BS = NG * 128 * 16 + NG * 128 * 32;
        for (int i = gt; i < N_WM + N_B2 + N_BS; i += NT) {
            float v[8]; bf16_t* dst;
            if (i < N_WM) {
                const int g = i / (256 * 64), r = i % (256 * 64), n = r / 64, k8 = (r % 64) * 8; dst = WM + ((size_t)g * 256 + n) * 512 + k8;
                if (n < 128) { const int p = n >> 1, ri = n & 1, s = k8 >> 4, c0 = k8 & 15; const float pr = POW[((size_t)(g * NP + p) * 33 + (31 - s)) * 2], pi = POW[((size_t)(g * NP + p) * 33 + (31 - s)) * 2 + 1];
#pragma unroll
                    for (int j = 0; j < 8; ++j) { const float br = BBAR[((size_t)(g * NP + p) * 16 + c0 + j) * 2], bi = BBAR[((size_t)(g * NP + p) * 16 + c0 + j) * 2 + 1]; v[j] = ri ? pr * bi + pi * br : pr * br - pi * bi; } }
                else {
#pragma unroll
                    for (int j = 0; j < 8; ++j) v[j] = 0.f; }
            } else {
                int g, t, c, k8; bool carry;
                const int i2 = i - N_WM;
                if (i2 < N_B2) { g = i2 / (512 * 16); const int r = i2 % (512 * 16), row = r / 16; k8 = (r % 16) * 8; t = row >> 4; c = row & 15; dst = B2 + ((size_t)g * 512 + row) * UGP + k8; carry = true; }
                else { const int i3 = i2 - N_B2;
                    if (i3 < NG * 128 * 16) { g = i3 / (128 * 16); const int r = i3 % (128 * 16), row = r / 16; k8 = (r % 16) * 8; t = row >> 4; c = row & 15; dst = BS + ((size_t)g * 256 + row) * 256 + k8; carry = true; }
                    else { const int i4 = i3 - NG * 128 * 16; g = i4 / (128 * 32); const int r = i4 % (128 * 32), row = 128 + r / 32; k8 = (r % 32) * 8; t = row; c = 0; dst = BS + ((size_t)g * 256 + row) * 256 + k8; carry = false; } }
                if (carry) {
#pragma unroll
                    for (int jj = 0; jj < 4; ++jj) { const int p = (k8 >> 1) + jj; const float pr = POW[((size_t)(g * NP + p) * 33 + (t + 1)) * 2], pi = POW[((size_t)(g * NP + p) * 33 + (t + 1)) * 2 + 1];
                        const float cr = in[19][(g * 16 + c) * NP + p], ci = in[20][(g * 16 + c) * NP + p]; v[2 * jj] = cr * pr - ci * pi; v[2 * jj + 1] = -(cr * pi + ci * pr); }
                } else { const int row = t, p = (row - 128) >> 1, ri = row & 1;
                    if (k8 < 128) { const float ar = POW[((size_t)(g * NP + p) * 33 + 8) * 2], ai = POW[((size_t)(g * NP + p) * 33 + 8) * 2 + 1];
#pragma unroll
                        for (int j = 0; j < 8; ++j) { const int p2 = (k8 + j) >> 1, ri2 = (k8 + j) & 1; v[j] = p2 != p ? 0.f : (ri == 0 ? (ri2 == 0 ? ar : -ai) : (ri2 == 0 ? ai : ar)); }
                    } else { const int s = (k8 - 128) >> 4, c0 = (k8 - 128) & 15; const float pr = POW[((size_t)(g * NP + p) * 33 + (7 - s)) * 2], pi = POW[((size_t)(g * NP + p) * 33 + (7 - s)) * 2 + 1];
#pragma unroll
                        for (int j = 0; j < 8; ++j) { const float br = BBAR[((size_t)(g * NP + p) * 16 + c0 + j) * 2], bi = BBAR[((size_t)(g * NP + p) * 16 + c0 + j) * 2 + 1]; v[j] = ri ? pr * bi + pi * br : pr * br - pi * bi; } }
                }
            }
            u32x4 w; w.x = cvtpk(v[0], v[1]); w.y = cvtpk(v[2], v[3]); w.z = cvtpk(v[4], v[5]); w.w = cvtpk(v[6], v[7]);
            *(u32x4*)dst = w;
        }
    } else {
        constexpr int N_B2 = NG * 512 * 64, N_BS = NG * 128 * 16;
        for (int i = gt; i < N_B2 + N_BS; i += NT) {
            int g, t, c, k8; bf16_t* dst;
            if (i < N_B2) { g = i / (512 * 64); const int r = i % (512 * 64), row = r / 64; k8 = (r % 64) * 8; t = row >> 4; c = row & 15; dst = B2 + ((size_t)g * 512 + row) * UGP + 128 + k8; }
            else { const int i2 = i - N_B2; g = i2 / (128 * 16); const int r = i2 % (128 * 16), row = r / 16; k8 = (r % 16) * 8; t = row >> 4; c = row & 15; dst = BS + ((size_t)g * 256 + row) * 256 + 128 + k8; }
            const int s = k8 >> 4, c0 = k8 & 15;
            u32x4 w = {0u, 0u, 0u, 0u};
            if (s <= t) { const f32x4 a = *(const f32x4*)(KTAB + ((size_t)(g * TCH + (t - s)) * 16 + c) * 16 + c0), b = *(const f32x4*)(KTAB + ((size_t)(g * TCH + (t - s)) * 16 + c) * 16 + c0 + 4); w = pack8(a, b); }
            *(u32x4*)dst = w;
        }
    }
}

constexpr int VROWB = 144;
__device__ __forceinline__ s16x4 vtr(LAS const unsigned char* p) { return __builtin_bit_cast(s16x4, __builtin_amdgcn_ds_read_tr16_b64_v4i16((LAS s16x4*)p)); }
__device__ __forceinline__ void attn_prompt_task(const bf16_t* QB, const bf16_t* KB, const bf16_t* VB, bf16_t* OG, float* LSE, int b, int g, int r, int h, int qt, LAS unsigned char* wl, int lane) {
    const int r32 = lane & 31, hi = lane >> 5, d = 1 << (2 * g), m0 = qt * 32;
    const long tok0 = (long)b * SEQ + r;
    const size_t coff = (size_t)g * 256 + h * 64;
    const bf16_t* qrow = QB + (size_t)(tok0 + (long)d * (m0 + r32)) * 768 + coff;
    bf16x8 qf[4];
#pragma unroll
    for (int ks = 0; ks < 4; ++ks) qf[ks] = *(const bf16x8*)(qrow + 16 * ks + 8 * hi);
    float m_run = -1e30f, l_run = 0.f; f32x16 o0 = {}, o1 = {};
    const int vkey = lane >> 3, vch = lane & 7;
    const int trq = (lane & 15) >> 2, trp = lane & 3, trc = 16 * ((lane >> 4) & 1) + 4 * trp;
#pragma unroll 1
    for (int kt = 4; kt >= 0; --kt) {
        const int kp0 = m0 - 128 + 32 * kt; if (kp0 < 0) continue;
        u32x4 vv[4];
#pragma unroll
        for (int i4 = 0; i4 < 4; ++i4) vv[i4] = *(const u32x4*)(VB + (size_t)(tok0 + (long)d * (kp0 + 8 * i4 + vkey)) * 768 + coff + vch * 8);
        const bf16_t* krow = KB + (size_t)(tok0 + (long)d * (kp0 + r32)) * 768 + coff;
        f32x16 s = {};
#pragma unroll
        for (int ks = 0; ks < 4; ++ks) { const bf16x8 kf = *(const bf16x8*)(krow + 16 * ks + 8 * hi); s = __builtin_amdgcn_mfma_f32_32x32x16_bf16(kf, qf[ks], s, 0, 0, 0); }
        float mx = -1e30f;
#pragma unroll
        for (int rr = 0; rr < 16; ++rr) { const int kk = (rr & 3) + 8 * (rr >> 2) + 4 * hi;
            if ((kt == 0 && kk < r32) || (kt == 4 && kk > r32)) s[rr] = -1e30f;
            mx = fmaxf(mx, s[rr]); }
        mx = fmaxf(mx, __shfl_xor(mx, 32));
        const float m_new = fmaxf(m_run, mx), alpha = __builtin_amdgcn_exp2f(m_run - m_new);
        float rsum = 0.f;
#pragma unroll
        for (int rr = 0; rr < 16; ++rr) { s[rr] = __builtin_amdgcn_exp2f(s[rr] - m_new); rsum += s[rr]; }
        rsum += __shfl_xor(rsum, 32);
        l_run = l_run * alpha + rsum; m_run = m_new;
#pragma unroll
        for (int rr = 0; rr < 16; ++rr) { o0[rr] *= alpha; o1[rr] *= alpha; }
        bf16x8 pf[2];
#pragma unroll
        for (int s2 = 0; s2 < 2; ++s2) { u32x4 w; w.x = cvtpk(s[8 * s2], s[8 * s2 + 1]); w.y = cvtpk(s[8 * s2 + 2], s[8 * s2 + 3]); w.z = cvtpk(s[8 * s2 + 4], s[8 * s2 + 5]); w.w = cvtpk(s[8 * s2 + 6], s[8 * s2 + 7]); pf[s2] = __builtin_bit_cast(bf16x8, w); }
#pragma unroll
        for (int i4 = 0; i4 < 4; ++i4) *(LAS u32x4*)(wl + (8 * i4 + vkey) * VROWB + vch * 16) = vv[i4];
        LDS_WAIT(); asm volatile("" ::: "memory");
#pragma unroll
        for (int s2 = 0; s2 < 2; ++s2) {
#pragma unroll
            for (int dt = 0; dt < 2; ++dt) {
                const int kb = 16 * s2 + 4 * hi + trq;
                const s16x4 lo = vtr(wl + kb * VROWB + (32 * dt + trc) * 2), hi4 = vtr(wl + (kb + 8) * VROWB + (32 * dt + trc) * 2);
                const bf16x8 vf = (bf16x8){lo[0], lo[1], lo[2], lo[3], hi4[0], hi4[1], hi4[2], hi4[3]};
                if (dt == 0) o0 = __builtin_amdgcn_mfma_f32_32x32x16_bf16(vf, pf[s2], o0, 0, 0, 0); else o1 = __builtin_amdgcn_mfma_f32_32x32x16_bf16(vf, pf[s2], o1, 0, 0, 0);
            }
        }
        LDS_WAIT(); asm volatile("" ::: "memory");
    }
    const float inv = 1.f / l_run;
    const size_t tok = (size_t)(tok0 + (long)d * (m0 + r32));
    bf16_t* orow = OG + ((size_t)g * M + tok) * 256 + h * 64;
#pragma unroll
    for (int rq = 0; rq < 4; ++rq) {
        u32x2 w0, w1; w0.x = cvtpk(o0[4 * rq] * inv, o0[4 * rq + 1] * inv); w0.y = cvtpk(o0[4 * rq + 2] * inv, o0[4 * rq + 3] * inv);
        w1.x = cvtpk(o1[4 * rq] * inv, o1[4 * rq + 1] * inv); w1.y = cvtpk(o1[4 * rq + 2] * inv, o1[4 * rq + 3] * inv);
        *(u32x2*)(orow + 8 * rq + 4 * hi) = w0; *(u32x2*)(orow + 32 + 8 * rq + 4 * hi) = w1;
    }
    if (hi == 0) LSE[((size_t)g * M + tok) * 4 + h] = m_run + __builtin_amdgcn_logf(l_run);
}

template <int CTRL> __device__ __forceinline__ float dpp_add(float v) { return v + __int_as_float(__builtin_amdgcn_update_dpp(0, __float_as_int(v), CTRL, 0xf, 0xf, true)); }
__device__ __forceinline__ float row16_sum(float v) { v = dpp_add<0xB1>(v); v = dpp_add<0x4E>(v); v = dpp_add<0x141>(v); v = dpp_add<0x140>(v); return v; }
__device__ __forceinline__ void attn_sample_unit(const bf16_t* QB, const float* cache, const float* knew, bf16_t* OG, float* LSE, int n, int g, int half, LAS float* xl, int wave, int lane) {
    const int l = 4 * half + (wave & 3), kh = wave >> 2;
    const int d = 1 << (2 * g), wb = 128 << (2 * g), row = MP + n * NSL + l;
    const u32x2 qw = *(const u32x2*)(QB + (size_t)row * 768 + g * 256 + lane * 4);
    const f32x4 q = {bflo(qw.x), bfhi(qw.x), bflo(qw.y), bfhi(qw.y)};
    const float* cb = cache + (size_t)n * wb * 512 + lane * 4;
    const float* nb = knew + (size_t)(n * NSL) * 512 + lane * 4;
    float m_run = -1e30f, l_run = 0.f; f32x4 o = {0.f, 0.f, 0.f, 0.f};
    const int ibeg = kh ? 65 : 0, iend = kh ? 129 : 65;
#pragma unroll 1
    for (int i0 = ibeg; i0 < iend; i0 += 8) {
        f32x4 kx[8], vx[8]; float sc[8];
#pragma unroll
        for (int j = 0; j < 8; ++j) { const int i = i0 + j; const int ridx = wb + l - d * (i < iend ? i : iend - 1);
            const float* p = ridx >= wb ? nb + (size_t)(ridx - wb) * 512 : cb + (size_t)ridx * 512;
            kx[j] = *(const f32x4*)p; vx[j] = *(const f32x4*)(p + 256); }
        float mx = -1e30f;
#pragma unroll
        for (int j = 0; j < 8; ++j) { float s = (q[0] * kx[j][0] + q[1] * kx[j][1]) + (q[2] * kx[j][2] + q[3] * kx[j][3]); s = row16_sum(s); if (i0 + j >= iend) s = -1e30f; sc[j] = s; mx = fmaxf(mx, s); }
        const float m_new = fmaxf(m_run, mx), alpha = __builtin_amdgcn_exp2f(m_run - m_new);
        l_run *= alpha; o = o * alpha; m_run = m_new;
#pragma unroll
        for (int j = 0; j < 8; ++j) { const float p = __builtin_amdgcn_exp2f(sc[j] - m_new); l_run += p; o += p * vx[j]; }
    }
    LAS float* slot = xl + ((wave & 3) * 64 + lane) * 8;
    if (kh) { slot[0] = m_run; slot[1] = l_run; *(LAS f32x4*)(slot + 4) = o; }
    __syncthreads();
    if (!kh) {
        const float m2 = slot[0], l2 = slot[1]; const f32x4 o2 = *(const LAS f32x4*)(slot + 4);
        const float mn = fmaxf(m_run, m2), a1 = __builtin_amdgcn_exp2f(m_run - mn), a2 = __builtin_amdgcn_exp2f(m2 - mn);
        l_run = l_run * a1 + l2 * a2; o = o * a1 + o2 * a2;
        const float inv = 1.f / l_run;
        u32x2 w; w.x = cvtpk(o[0] * inv, o[1] * inv); w.y = cvtpk(o[2] * inv, o[3] * inv);
        *(u32x2*)(OG + ((size_t)g * M + row) * 256 + lane * 4) = w;
        if ((lane & 15) == 0) LSE[((size_t)g * M + row) * 4 + (lane >> 4)] = mn + __builtin_amdgcn_logf(l_run);
    }
}

constexpr int N_ATT_TICKETS = 1536, CW_TICK = 8192;
__device__ __forceinline__ void phase_attention(Frame& F, int tick_word, int t_lo, int count, int only = -1) {
    KArgs ka = kargs(); unsigned char* ws = ka->ws;
    const bf16_t* QB = (const bf16_t*)(ws + WS_QB); const bf16_t* KB = (const bf16_t*)(ws + WS_KB); const bf16_t* VB = (const bf16_t*)(ws + WS_VB);
    bf16_t* OG = (bf16_t*)(ws + WS_OG); float* LSE = (float*)(ws + WS_LSE);
    unsigned* ctr = (unsigned*)(ws + WS_CTL) + CW_TICK + 64 * tick_word;
    LAS unsigned char* wl = F.lds + F.wave * 16384;
    volatile LAS unsigned* tk = (volatile LAS unsigned*)(F.lds + MISC_OFF + 64);
    for (;;) {
        __syncthreads();
        if (F.tid == 0) tk[0] = __hip_atomic_fetch_add(ctr, 1u, __ATOMIC_RELAXED, __HIP_MEMORY_SCOPE_AGENT);
        __syncthreads();
        const int tt = (int)tk[0]; if (tt >= count) break;
        const int t = t_lo + tt;
        if (only >= 0 && (t & 1) != only) continue;
        if ((t & 1) == 0) { const int su = t >> 1, g = 2 - (su % 3), rest = su / 3, n = rest >> 1, half = rest & 1;
            const float* cache = g == 0 ? ka->in[4] : g == 1 ? ka->in[5] : ka->in[6]; const float* knew = ka->out + (g == 0 ? O_KVS0 : g == 1 ? O_KVS1 : O_KVS2);
            attn_sample_unit(QB, cache, knew, OG, LSE, n, g, half, (LAS float*)(F.lds + 8 * 16384 - 8192), F.wave, F.lane);
        } else { const int V = t >> 1, g = V >> 8, rem = V & 255, b = rem >> 7, rem2 = rem & 127, h = rem2 & 3, rem3 = rem2 >> 2, d = 1 << (2 * g), r = rem3 % d, qb = rem3 / d;
            attn_prompt_task(QB, KB, VB, OG, LSE, b, g, r, h, qb * 8 + F.wave, wl, F.lane);
        }
    }
}

__device__ __forceinline__ void phase_attn_merge(Frame& F) {
    KArgs ka = kargs(); unsigned char* ws = ka->ws; const bf16_t* OG = (const bf16_t*)(ws + WS_OG); const float* LSE = (const float*)(ws + WS_LSE); bf16_t* YA = (bf16_t*)(ws + WS_YGA) + DSSM;
    for (int row = F.gw; row < M; row += F.NGW) {
        const int h = F.lane >> 4;
        const float l0 = LSE[((size_t)0 * M + row) * 4 + h], l1 = LSE[((size_t)1 * M + row) * 4 + h], l2 = LSE[((size_t)2 * M + row) * 4 + h];
        const float mx = fmaxf(l0, fmaxf(l1, l2)); float w0 = __builtin_amdgcn_exp2f(l0 - mx), w1 = __builtin_amdgcn_exp2f(l1 - mx), w2 = __builtin_amdgcn_exp2f(l2 - mx);
        const float inv = 1.f / (w0 + w1 + w2); w0 *= inv; w1 *= inv; w2 *= inv;
        const u32x2 a = *(const u32x2*)(OG + ((size_t)0 * M + row) * 256 + F.lane * 4), b = *(const u32x2*)(OG + ((size_t)1 * M + row) * 256 + F.lane * 4), c = *(const u32x2*)(OG + ((size_t)2 * M + row) * 256 + F.lane * 4);
        u32x2 w; w.x = cvtpk(w0 * bflo(a.x) + w1 * bflo(b.x) + w2 * bflo(c.x), w0 * bfhi(a.x) + w1 * bfhi(b.x) + w2 * bfhi(c.x));
        w.y = cvtpk(w0 * bflo(a.y) + w1 * bflo(b.y) + w2 * bflo(c.y), w0 * bfhi(a.y) + w1 * bfhi(b.y) + w2 * bfhi(c.y));
        *(u32x2*)(YA + (size_t)row * KMRG + F.lane * 4) = w;
    }
}

__device__ __forceinline__ void ssm_scan_item(Frame& F, int b, int g) {
    KArgs ka = kargs(); unsigned char* ws = ka->ws; float* outp = ka->out; const float* SC = (const float*)(ws + WS_SC); const float* POW = (const float*)(ws + WS_POW); bf16_t* UGX = (bf16_t*)(ws + WS_UGX);
    const float* src = SC + ((size_t)g * NCR + b * NCH) * 128;
    LAS f32x4* L4 = (LAS f32x4*)F.lds;
    __syncthreads();
#pragma unroll 4
    for (int i = F.tid; i < NCH * 128 / 4; i += NWAVES * 64) L4[i] = ((const f32x4*)src)[i];
    __syncthreads();
    if (F.wave == 0) {
        const int p = F.lane; const float ar = POW[((size_t)(g * NP + p) * 33 + 32) * 2], ai = POW[((size_t)(g * NP + p) * 33 + 32) * 2 + 1];
        float hr = 0.f, hi = 0.f; const LAS f32x2* L2 = (const LAS f32x2*)F.lds;
#pragma unroll 8
        for (int c = 0; c < NCH; ++c) {
            *(unsigned*)(UGX + ((size_t)g * NCR + b * NCH + c) * UGP + 2 * p) = cvtpk(hr, hi);
            const f32x2 s = L2[c * 64 + p];
            const float nr = ar * hr - ai * hi + s.x, ni = ar * hi + ai * hr + s.y; hr = nr; hi = ni;
        }
        float* o = outp + O_SSMP + ((size_t)(b * NG + g) * NP + p) * 2; o[0] = hr; o[1] = hi;
    }
    VM_WAIT(); __syncthreads();
    __builtin_amdgcn_fence(__ATOMIC_ACQUIRE, "agent"); VM_WAIT();
    __syncthreads();
}

__device__ __forceinline__ void phase_final_norm(Frame& F) {
    KArgs ka = kargs(); const float* ssq4 = (const float*)(ka->ws + WS_SSQ) + 4 * (size_t)M; const float* gf = ka->in[33]; float* outp = ka->out;
    f32x4 gv[4];
#pragma unroll
    for (int j = 0; j < 4; ++j) gv[j] = ((const f32x4*)gf)[F.lane + 64 * j];
    for (int m = F.gw; m < M; m += F.NGW) {
        const float rs = rs_of(ssq4[m]); f32x4* xr = (f32x4*)(outp + (size_t)m * DM);
#pragma unroll
        for (int j = 0; j < 4; ++j) { f32x4 v = xr[F.lane + 64 * j]; xr[F.lane + 64 * j] = v * rs * gv[j]; }
    }
}

constexpr int N_PHASES = 12;
__global__ void __launch_bounds__(NWAVES * 64, 2) mk_fwd(Args args) {
    extern __shared__ __attribute__((aligned(16))) unsigned char lds_raw[];
    Frame F;
    F.lds = (LAS unsigned char*)lds_raw; F.tid = threadIdx.x; F.lane = F.tid & 63; F.wave = __builtin_amdgcn_readfirstlane(F.tid >> 6);
    F.G = gridDim.x; F.gw = blockIdx.x * NWAVES + F.wave; F.NGW = F.G * NWAVES;
    KArgs ka0 = kargs();
    unsigned char* ws = ka0->ws;
    volatile LAS unsigned* MISC = (volatile LAS unsigned*)(F.lds + MISC_OFF);
    for (int u = F.tid; u < (LDS_BYTES - LDSCTL_OFF) / 4; u += NWAVES * 64) ((LAS unsigned*)(F.lds + LDSCTL_OFF))[u] = 0u;
    __syncthreads();
    XcdBarrier bar; bar.bar = (unsigned*)(ws + WS_CTL) + CW_BAR; bar.x = 0; bar.st = nullptr;
    if (MK_N_LAUNCHES == 1) bar = xcd_barrier_post((unsigned*)(ws + WS_CTL) + CW_BAR, MISC + 8);
    const int lo = ka0->ph_lo, hi = ka0->ph_hi;
#ifdef PROBE_T
    if (F.tid == 0) { const unsigned long long t_ = __builtin_amdgcn_s_memrealtime(); MISC[28] = (unsigned)t_; MISC[29] = (unsigned)(t_ >> 32); }
#endif
#define IN(k) (lo <= (k) && (k) < hi)
#ifdef PROBE_T
#define SEAM(k) do { if (IN(k) && IN((k) + 1)) xcd_barrier(bar); if (F.tid == 0) { const unsigned long long t_ = __builtin_amdgcn_s_memrealtime(); MISC[32 + 2 * (k)] = (unsigned)t_; MISC[33 + 2 * (k)] = (unsigned)(t_ >> 32); } } while (0)
#else
#define SEAM(k) do { if (IN(k) && IN((k) + 1)) xcd_barrier(bar); } while (0)
#endif
    LAS unsigned char* ring = F.lds;
    const int cid = (int)blockIdx.x;
#define WSB(off) ((const bf16_t*)(ka->ws + (off)))
#define RUN(CFG, Aoff, Boff, C0, EA) do { Epi<CFG::KIND> E_{EA}; pg8::gemm_phase<CFG>(ring, Aoff, Boff, F.G, cid, C0, E_); } while (0)
#define MINI(CFG, Aoff, Boff, EA) do { for (int mu_ = cid; mu_ < 256; mu_ += F.G) mini_gemm<CFG::KIND, CFG::LDA, CFG::LDB, CFG::KK>(F, Aoff, Boff, mu_, EA); } while (0)
#define EA0() KArgs ka = kargs(); EpiArgs ea{}; ea.ws = ka->ws; ea.out = ka->out; ea.dskip = ka->in[21]

    for (int rep_ = 0; rep_ < 1 + ((PROBE_DUP >> 0) & 1); ++rep_) { if (IN(0)) { phase_prologue(F); } SEAM(0); }
    if (IN(1)) {
        phase_build_ssm(F, 1);
        EA0();
        { EpiArgs e = ea; e.ssq_i = 0; RUN(CfgGU, WSB(WS_XB), WSB(WS_W1GU), 0, e); }
        { RUN(CfgPP, WSB(WS_PB), WSB(WS_WPP), (M / 256 * 22) % 256, ea); }
    } SEAM(1);
    if (IN(2)) { phase_build_ssm(F, 2); EA0(); EpiArgs e = ea; e.base0 = ka->in[0]; e.base1 = ka->in[1]; e.ssq_o = 1; e.alpha = 0.5f; RUN(CfgDown, WSB(WS_HID), WSB(WS_W1D), 0, e); MINI(CfgDown, WSB(WS_HID), WSB(WS_W1D), e); } SEAM(2);
    if (IN(3)) { EA0(); EpiArgs e = ea; e.ssq_i = 1; RUN(CfgWin, WSB(WS_XB), WSB(WS_WIN), 0, e); } SEAM(3);
    if (IN(4)) {
        { EA0(); RUN(CfgS1, WSB(WS_UGX) + 128, WSB(WS_WM), 0, ea); RUN(CfgSS, WSB(WS_USX), WSB(WS_BS), 64, ea); }
        phase_attention(F, 0, 0, N_ATT_TICKETS / 2);
#ifdef PROBE_ATT
        phase_attention(F, 2, 0, N_ATT_TICKETS / 2, PROBE_ATT);
#endif
    } SEAM(4);
    if (IN(5)) {
        if (cid < NB * NG) { ssm_scan_item(F, cid & 1, cid >> 1); EA0(); RUN(CfgS2, WSB(WS_UGX), WSB(WS_B2), 0, ea); }
        phase_attention(F, 1, N_ATT_TICKETS / 2, N_ATT_TICKETS / 2);
#ifdef PROBE_ATT
        phase_attention(F, 3, N_ATT_TICKETS / 2, N_ATT_TICKETS / 2, PROBE_ATT);
#endif
    } SEAM(5);
    if (IN(6)) { { EA0(); RUN(CfgGLU, WSB(WS_YS), WSB(WS_WGLU), 0, ea); } phase_attn_merge(F); } SEAM(6);
    if (IN(7)) { EA0(); RUN(CfgMrg, WSB(WS_YGA), WSB(WS_WBS), 0, ea); MINI(CfgMrg, WSB(WS_YGA), WSB(WS_WBS), ea); } SEAM(7);
    if (IN(8)) { EA0(); EpiArgs e = ea; e.base0 = ka->out; e.base1 = ka->out + (size_t)MP * DM; e.ssq_o = 2; e.alpha = 1.0f; RUN(CfgOut, WSB(WS_MRG), WSB(WS_WOUT), 0, e); MINI(CfgOut, WSB(WS_MRG), WSB(WS_WOUT), e); } SEAM(8);
    if (IN(9)) { EA0(); EpiArgs e = ea; e.ssq_i = 2; RUN(CfgGU, WSB(WS_XB), WSB(WS_W2GU), 0, e); } SEAM(9);
    if (IN(10)) { EA0(); EpiArgs e = ea; e.base0 = ka->out; e.base1 = ka->out + (size_t)MP * DM; e.ssq_o = 3; e.alpha = 0.5f; RUN(CfgDown, WSB(WS_HID), WSB(WS_W2D), 0, e); MINI(CfgDown, WSB(WS_HID), WSB(WS_W2D), e); } SEAM(10);
    if (IN(11)) { EA0(); EpiArgs e = ea; e.base0 = ka->out; e.base1 = ka->out + (size_t)MP * DM; e.ssq_i = 3; e.ssq_o = 4; RUN(CfgPle, WSB(WS_XB), WSB(WS_WPG), 0, e); MINI(CfgPle, WSB(WS_XB), WSB(WS_WPG), e); } SEAM(11);
    if (IN(12)) { phase_final_norm(F); }
#ifdef PROBE_T
    __syncthreads();
    if (blockIdx.x == 0) { KArgs ka = kargs(); const unsigned long long t1 = ((unsigned long long)MISC[33 + 2 * PROBE_T] << 32) | MISC[32 + 2 * PROBE_T];
        unsigned long long t0 = PROBE_T > 0 ? (((unsigned long long)MISC[31 + 2 * PROBE_T] << 32) | MISC[30 + 2 * PROBE_T]) : (((unsigned long long)MISC[29] << 32) | MISC[28]);
        const float us = (float)(long long)(t1 - t0) * 0.01f; float* sp = ka->out + O_SSMP;
        for (int i = F.tid; i < 8192; i += 512) sp[i] *= (1.f + us * 0.001f); }
#endif
#undef IN
#undef SEAM
}

extern "C" void kernel_launch(void* const* d_in, const int* in_sizes, int n_in, void* d_out, int out_size, void* d_ws, size_t ws_size, hipStream_t stream) {
    static int grid = 0;
    if (grid == 0) {
        if (n_in != 34 || out_size != (int)O_END || ws_size < WS_END) { fprintf(stderr, "kernel_launch: unexpected shapes (n_in %d, out %d, ws %zu)\n", n_in, out_size, ws_size); grid = -1; return; }
        int dev = 0, cus = 0, per_cu = 0;
        if (hipGetDevice(&dev) != hipSuccess || hipDeviceGetAttribute(&cus, hipDeviceAttributeMultiprocessorCount, dev) != hipSuccess) { grid = -1; return; }
        if (hipFuncSetAttribute((const void*)mk_fwd, hipFuncAttributeMaxDynamicSharedMemorySize, LDS_BYTES) != hipSuccess) { fprintf(stderr, "kernel_launch: hipFuncSetAttribute failed\n"); grid = -1; return; }
        if (hipOccupancyMaxActiveBlocksPerMultiprocessor(&per_cu, (const void*)mk_fwd, NWAVES * 64, LDS_BYTES) != hipSuccess || per_cu < 1) { fprintf(stderr, "kernel_launch: occupancy query says %d\n", per_cu); }
        (void)hipGetLastError();
        grid = cus;
    }
    if (grid < 0) return;
    (void)hipMemsetAsync((char*)d_ws + WS_CTL, 0, CTL_ZERO_BYTES, stream);
    Args a{};
    for (int i = 0; i < 34; ++i) a.in[i] = (const float*)d_in[i];
    a.out = (float*)d_out; a.ws = (unsigned char*)d_ws;
    if (MK_N_LAUNCHES == 1) { a.ph_lo = 0; a.ph_hi = N_PHASES + 1; hipLaunchKernelGGL(mk_fwd, dim3(grid), dim3(NWAVES * 64), LDS_BYTES, stream, a); }
    else for (int p = 0; p <= N_PHASES; ++p) { a.ph_lo = p; a.ph_hi = p + 1; hipLaunchKernelGGL(mk_fwd, dim3(grid), dim3(NWAVES * 64), LDS_BYTES, stream, a); }
}
```

```cpp
#include <hip/hip_runtime.h>
#include <cstdio>
#include <cstdint>

#ifndef MK_N_LAUNCHES
#define MK_N_LAUNCHES 1
#endif

#ifndef PROBE_DUP
#define PROBE_DUP 0
#endif
#define LAS __attribute__((address_space(3)))
#define GAS __attribute__((address_space(1)))
typedef unsigned short bf16_t;
typedef short bf16x8 __attribute__((ext_vector_type(8)));
typedef short s16x4 __attribute__((ext_vector_type(4)));
typedef float f32x4 __attribute__((ext_vector_type(4)));
typedef float f32x2 __attribute__((ext_vector_type(2)));
typedef float f32x16 __attribute__((ext_vector_type(16)));
typedef unsigned u32x4 __attribute__((ext_vector_type(4)));
typedef unsigned u32x2 __attribute__((ext_vector_type(2)));
typedef __bf16 bf16x2_t __attribute__((ext_vector_type(2)));

constexpr int DM = 1024, SEQ = 8192, NB = 2, MP = NB * SEQ, NSB = 128, NSL = 8, MS = NSB * NSL, M = MP + MS;
constexpr int DFF = 2816, DPLE = 256, DSSM = 512, NG = 32, NP = 64, DIN = 4864;
constexpr int KMRG = 768;
constexpr int TCH = 32, NCH = SEQ / TCH, NCR = NB * NCH;
constexpr int UGP = 128 + TCH * 16;
constexpr float EPS = 1e-6f, LOG2E = 1.4426950408889634f, QSCALE = 0.125f * 1.4426950408889634f;

constexpr size_t O_Y = 0, O_KVP0 = (size_t)M * DM, O_KVP1 = O_KVP0 + 131072, O_KVP2 = O_KVP1 + 524288, O_SSMP = O_KVP2 + 2097152,
                 O_KVS0 = O_SSMP + 8192, O_KVS1 = O_KVS0 + 524288, O_KVS2 = O_KVS1 + 524288, O_SSMS = O_KVS2 + 524288, O_END = O_SSMS + 524288;

constexpr size_t MiB = 1u << 20;
constexpr size_t WS_CTL = 0, CTL_ZERO_BYTES = 1 * MiB;
constexpr size_t WS_SSQ = 512 * 1024;
constexpr size_t WS_W1GU = 2 * MiB, WS_W1D = 14 * MiB, WS_WIN = 20 * MiB, WS_WGLU = 30 * MiB, WS_WBS = 31 * MiB, WS_WBA = 32 * MiB, WS_WOUT = 33 * MiB,
                 WS_W2GU = 36 * MiB, WS_W2D = 48 * MiB, WS_WPG = 54 * MiB, WS_WPP = 57 * MiB, WS_WM = 58 * MiB, WS_B2 = 67 * MiB, WS_BS = 88 * MiB,
                 WS_KTAB = 93 * MiB, WS_POW = 95 * MiB, WS_BBAR = 96 * MiB;
constexpr size_t WS_XB = 100 * MiB, WS_HID = 136 * MiB, WS_QB = 232 * MiB, WS_KB = 258 * MiB, WS_VB = 284 * MiB, WS_SA = 310 * MiB, WS_SB = 346 * MiB,
                 WS_UGX = 382 * MiB, WS_USX = 403 * MiB, WS_SC = 406 * MiB, WS_YS = 415 * MiB, WS_YGOLD = 433 * MiB, WS_OG = 451 * MiB, WS_LSE = 478 * MiB,
                 WS_YATTOLD = 480 * MiB, WS_YGA = 490 * MiB  , WS_MRG = 526 * MiB, WS_PP = 562 * MiB, WS_PB = 598 * MiB, WS_END = 608 * MiB;
static_assert(WS_W1GU + (size_t)5632 * 1024 * 2 <= WS_W1D && WS_W1D + (size_t)1024 * 2816 * 2 <= WS_WIN && WS_WIN + (size_t)DIN * 1024 * 2 <= WS_WGLU, "ws map 1");
static_assert(WS_WM + (size_t)NG * 256 * 512 * 2 <= WS_B2 && WS_B2 + (size_t)NG * 512 * UGP * 2 <= WS_BS && WS_BS + (size_t)NG * 256 * 256 * 2 <= WS_KTAB, "ws map 2");
static_assert(WS_XB + (size_t)M * DM * 2 <= WS_HID && WS_HID + (size_t)M * DFF * 2 <= WS_QB && WS_QB + (size_t)M * 768 * 2 <= WS_KB && WS_SA + (size_t)M * DM * 2 <= WS_SB, "ws map 3");
static_assert(WS_UGX + (size_t)NG * NCR * UGP * 2 <= WS_USX && WS_USX + (size_t)(NG + 1) * 128 * 256 * 2 <= WS_SC && WS_SC + (size_t)NG * NCR * 128 * 4 <= WS_YS, "ws map 4");
static_assert(WS_YS + (size_t)M * 512 * 2 <= WS_YGOLD && WS_OG + (size_t)3 * M * 256 * 2 <= WS_LSE && WS_LSE + (size_t)3 * M * 4 * 4 <= WS_YATTOLD && WS_YGA + (size_t)M * 768 * 2 <= WS_MRG, "ws map 5");
static_assert(WS_PB + (size_t)M * 256 * 2 <= WS_END && 5 * (size_t)M * 4 + WS_SSQ <= CTL_ZERO_BYTES, "ws map 6");
constexpr int CW_BAR = 4096;

constexpr int RING_BYTES = 131072, LDSCTL_OFF = RING_BYTES, MISC_OFF = LDSCTL_OFF + 320, LDS_BYTES = 147456;
constexpr int NWAVES = 8;

__device__ __forceinline__ unsigned cvtpk(float lo, float hi) { f32x2 v = {lo, hi}; bf16x2_t b = __builtin_convertvector(v, bf16x2_t); return __builtin_bit_cast(unsigned, b); }
__device__ __forceinline__ float bflo(unsigned w) { return __uint_as_float(w << 16); }
__device__ __forceinline__ float bfhi(unsigned w) { return __uint_as_float(w & 0xffff0000u); }
__device__ __forceinline__ u32x4 pack8(f32x4 a, f32x4 b) { u32x4 w; w.x = cvtpk(a[0], a[1]); w.y = cvtpk(a[2], a[3]); w.z = cvtpk(b[0], b[1]); w.w = cvtpk(b[2], b[3]); return w; }
__device__ __forceinline__ void unpack8(u32x4 w, f32x4& a, f32x4& b) { a = (f32x4){bflo(w.x), bfhi(w.x), bflo(w.y), bfhi(w.y)}; b = (f32x4){bflo(w.z), bfhi(w.z), bflo(w.w), bfhi(w.w)}; }
__device__ __forceinline__ float sigmoidf_(float x) { return __builtin_amdgcn_rcpf(1.f + __builtin_amdgcn_exp2f(-x * LOG2E)); }
__device__ __forceinline__ f32x4 sigmoid4(f32x4 v) { return (f32x4){sigmoidf_(v[0]), sigmoidf_(v[1]), sigmoidf_(v[2]), sigmoidf_(v[3])}; }
__device__ __forceinline__ float gelu_tanh(float y) { const float z2 = 1.5957691216057308f * (y + 0.044715f * y * y * y); return y * sigmoidf_(z2); }
__device__ __forceinline__ f32x4 gelu4(f32x4 v) { return (f32x4){gelu_tanh(v[0]), gelu_tanh(v[1]), gelu_tanh(v[2]), gelu_tanh(v[3])}; }
__device__ __forceinline__ float rs_of(float ssq) { return __builtin_amdgcn_rsqf(ssq * (1.f / DM) + EPS); }
#define LDS_WAIT() asm volatile("s_waitcnt lgkmcnt(0)" ::: "memory")
#define VM_WAIT() asm volatile("s_waitcnt vmcnt(0)" ::: "memory")

namespace pg8 {
constexpr int BM = 256, BK = 64, HALF = 128, HTB = HALF * BK * 2, NXCD = 8, WGM = 8;
__device__ __forceinline__ int lds_byte(int r, int c) { const int st = (r >> 4) * 2 + (c >> 5), rr = r & 15, cc = c & 31, ob = rr * 64 + cc * 2; return st * 1024 + (ob ^ (((ob >> 9) & 1) << 5)); }
__device__ __forceinline__ void stage_rc(int b, int& R, int& C) { const int st = b / 1024, sb = b % 1024, swz = sb ^ (((sb >> 9) & 1) << 5); R = (st >> 1) * 16 + swz / 64; C = (st & 1) * 32 + (swz % 64) / 2; }
__device__ __forceinline__ int perm32(int rho) { const int n = rho >> 4, i = rho & 15; return 8 * (i >> 2) + 4 * n + (i & 3); }

struct Unit { int pm, pn, g, part; };
template <int nM, int nN, int nG, int UPC = 0, bool DUAL = false> struct Order {
    static constexpr int nwg = nM * nN * nG;
    int G, c;
    __device__ __forceinline__ void init(int G_, int c_, int c0) { G = G_; c = (c_ - c0 % G_ + G_) % G_; }
    __device__ __forceinline__ bool next(int i, Unit& u) const {
        u.part = 0; if constexpr (DUAL) { u.part = i & 1; i >>= 1; }
        long L = (long)i * G + c; if constexpr (UPC > 0) { if (i >= UPC) return false; L = (long)c * UPC + i; }
        if (L >= nwg) return false;
        int wgid = (int)L;
        if constexpr (nG == 1) {
            { constexpr int q = nwg / NXCD, r = nwg % NXCD; const int xcd = wgid % NXCD, off = wgid / NXCD; wgid = (xcd < r ? xcd * (q + 1) : r * (q + 1) + (xcd - r) * q) + off; }
            constexpr int nig = WGM * nN; const int gid = wgid / nig, fm = gid * WGM, gsz = (nM - fm) < WGM ? (nM - fm) : WGM;
            u.pm = fm + ((wgid % nig) % gsz); u.pn = (wgid % nig) / gsz; u.g = 0;
        } else { u.g = wgid / (nM * nN); const int r = wgid % (nM * nN); u.pm = r / nN; u.pn = r % nN; }
        return true;
    }
};

template <class C, class Epi>
__device__ __forceinline__ void gemm_phase(LAS unsigned char* lds, const bf16_t* gA, const bf16_t* gBt, int Gsz, int cu, int c0, const Epi& E) {
    int tid = threadIdx.x; asm volatile("" : "+v"(tid));
    const int wid = __builtin_amdgcn_readfirstlane(tid >> 6), lane = tid & 63, wr = wid >> 2, wc = wid & 3, fr = lane & 15, fq = lane >> 4;
    constexpr int nt = C::KK / BK;
    struct { const bf16_t* A; const bf16_t* Bt; } g{gA, gBt};
    Order<C::NM, C::NN, C::NGRP, C::UPC, (C::MIDT > 0)> S; S.init(Gsz, cu, c0);
    unsigned voffA[2], voffB[2];
#pragma unroll
    for (int i = 0; i < 2; ++i) { int R, Cc; stage_rc(tid * 16 + i * 8192, R, Cc); const int Rb = (R & ~31) + perm32(R & 31);
        voffA[i] = (unsigned)(R * C::LDA + Cc) * 2u; voffB[i] = (unsigned)(Rb * C::LDB + Cc) * 2u; }
    constexpr size_t kstep = (size_t)(BK * 2);
    constexpr size_t hstepA = (size_t)HALF * C::LDA * 2, hstepB = (size_t)HALF * C::LDB * 2;
    const unsigned ldsw = (unsigned)wid * 1024u;
    const int aoff = lds_byte(wr * 64 + fr, fq * 8), boff = lds_byte(wc * 32 + fr, fq * 8);
#define PG8_SA(b, h) (((b) * 2 + (h)) * HTB)
#define PG8_SB(b, h) ((4 + (b) * 2 + (h)) * HTB)
#define PG8_STAGE(bufoff, gbase, voff) do { _Pragma("unroll") for (int _i = 0; _i < 2; ++_i) \
        __builtin_amdgcn_global_load_lds((const unsigned*)((const char*)(gbase) + (voff)[_i]), (LAS unsigned*)(lds + (bufoff) + ldsw + _i * 8192), 16, 0, 0); } while (0)
#define PG8_LDA(dst, b, h) do { _Pragma("unroll") for (int m = 0; m < 4; ++m) _Pragma("unroll") for (int k = 0; k < 2; ++k) dst[m][k] = *(const LAS bf16x8*)(lds + PG8_SA(b, h) + aoff + m * 2048 + k * 1024); } while (0)
#define PG8_LDB(dst, b, h) do { _Pragma("unroll") for (int n = 0; n < 2; ++n) _Pragma("unroll") for (int k = 0; k < 2; ++k) dst[n][k] = *(const LAS bf16x8*)(lds + PG8_SB(b, h) + boff + n * 2048 + k * 1024); } while (0)
#define PG8_MMA(ai, bj, At, Bt) do { __builtin_amdgcn_s_setprio(1); _Pragma("unroll") for (int m = 0; m < 4; ++m) _Pragma("unroll") for (int n = 0; n < 2; ++n) _Pragma("unroll") for (int k = 0; k < 2; ++k) \
        acc[ai][bj][m][n] = __builtin_amdgcn_mfma_f32_16x16x32_bf16(Bt[n][k], At[m][k], acc[ai][bj][m][n], 0, 0, 0); __builtin_amdgcn_s_setprio(0); } while (0)
#define PG8_WAIT_V(n) asm volatile("s_waitcnt vmcnt(" #n ")" ::: "memory")
#define PG8_WAIT_L(n) asm volatile("s_waitcnt lgkmcnt(" #n ")" ::: "memory")
#define PG8_BAR __builtin_amdgcn_s_barrier()
#define PG8_SCHED __builtin_amdgcn_sched_barrier(0)
    Unit cur, nxt; int ui = 0;
    if (!S.next(0, cur)) return;
    f32x4 acc[2][2][4][2];
#pragma unroll
    for (int a = 0; a < 2; ++a)
#pragma unroll
        for (int b = 0; b < 2; ++b)
#pragma unroll
            for (int m = 0; m < 4; ++m)
#pragma unroll
                for (int n = 0; n < 2; ++n) acc[a][b][m][n] = (f32x4){0.f, 0.f, 0.f, 0.f};
    bf16x8 At[4][2], B0[2][2], B1[2][2];
    const char* cA = (const char*)(g.A + (size_t)cur.g * C::GSA) + (size_t)cur.pm * 2 * hstepA; const char* cB = (const char*)(g.Bt + (size_t)cur.g * C::GSB) + (size_t)cur.pn * 2 * hstepB;
    PG8_STAGE(PG8_SB(0, 0), cB, voffB); PG8_STAGE(PG8_SB(0, 1), cB + hstepB, voffB); PG8_STAGE(PG8_SA(0, 0), cA, voffA); PG8_STAGE(PG8_SA(0, 1), cA + hstepA, voffA);
    if (wr == 1) PG8_BAR;
    PG8_WAIT_V(2); PG8_BAR;
    PG8_STAGE(PG8_SB(1, 0), cB + kstep, voffB); PG8_STAGE(PG8_SA(1, 0), cA + kstep, voffA); PG8_STAGE(PG8_SB(1, 1), cB + hstepB + kstep, voffB);
    PG8_WAIT_V(6); PG8_BAR;
    for (;;) {
        const bool has_next = S.next(ui + 1, nxt);
        const size_t poff = (C::MIDT > 0 && has_next && nxt.part) ? (size_t)C::MIDT * kstep : 0;
        const char* nA = has_next ? (const char*)(g.A + (size_t)nxt.g * C::GSA) + (size_t)nxt.pm * 2 * hstepA + poff : cA;
        const char* nB = has_next ? (const char*)(g.Bt + (size_t)nxt.g * C::GSB) + (size_t)nxt.pn * 2 * hstepB + poff : cB;
        const int ntc = C::MIDT > 0 ? (cur.part ? nt - C::MIDT : C::MIDT) : nt;
#pragma unroll 1
        for (int t = 0; t < ntc; t += 2) {
            const bool last = (t == ntc - 2);
            const char* a1 = cA + (size_t)(t + 1) * kstep;
            const char* a2 = last ? nA : cA + (size_t)(t + 2) * kstep; const char* b2 = last ? nB : cB + (size_t)(t + 2) * kstep;
            const char* a3 = a2 + kstep; const char* b3 = b2 + kstep;
            PG8_LDB(B0, 0, 0); PG8_LDB(B1, 0, 1); PG8_SCHED; PG8_LDA(At, 0, 0); PG8_STAGE(PG8_SA(1, 1), a1 + hstepA, voffA);
            PG8_WAIT_V(8); PG8_WAIT_L(0); PG8_BAR; PG8_MMA(0, 0, At, B0); PG8_MMA(0, 1, At, B1); PG8_BAR; PG8_SCHED;
            PG8_LDA(At, 0, 1); PG8_STAGE(PG8_SB(0, 0), b2, voffB); PG8_STAGE(PG8_SB(0, 1), b2 + hstepB, voffB); PG8_STAGE(PG8_SA(0, 0), a2, voffA);
            PG8_WAIT_V(8); PG8_WAIT_L(0); PG8_BAR; PG8_MMA(1, 0, At, B0); PG8_MMA(1, 1, At, B1); PG8_BAR; PG8_SCHED;
            PG8_LDB(B0, 1, 0); PG8_LDB(B1, 1, 1); PG8_SCHED; PG8_LDA(At, 1, 0); PG8_STAGE(PG8_SA(0, 1), a2 + hstepA, voffA);
            PG8_WAIT_V(8); PG8_WAIT_L(0); PG8_BAR; PG8_MMA(0, 0, At, B0); PG8_MMA(0, 1, At, B1); PG8_BAR; PG8_SCHED;
            PG8_LDA(At, 1, 1); PG8_STAGE(PG8_SB(1, 0), b3, voffB); PG8_STAGE(PG8_SB(1, 1), b3 + hstepB, voffB); PG8_STAGE(PG8_SA(1, 0), a3, voffA);
            PG8_WAIT_V(8); PG8_WAIT_L(0); PG8_BAR; PG8_MMA(1, 0, At, B0); PG8_MMA(1, 1, At, B1); PG8_BAR; PG8_SCHED;
        }
        if (wr == 0) PG8_BAR;
        const bool midp = C::MIDT > 0 && cur.part == 0;
        if (midp) E.mid(acc, cur, wr, wc, fr, fq); else E(acc, cur, wr, wc, fr, fq);
        if (!has_next) break;
        if (!midp) {
#pragma unroll
        for (int a = 0; a < 2; ++a)
#pragma unroll
            for (int b = 0; b < 2; ++b)
#pragma unroll
                for (int m = 0; m < 4; ++m)
#pragma unroll
                    for (int n = 0; n < 2; ++n) acc[a][b][m][n] = (f32x4){0.f, 0.f, 0.f, 0.f};
        }
        cur = nxt; cA = nA; cB = nB; ++ui;
        if (wr == 1) PG8_BAR;
    }
    PG8_WAIT_V(0);
    PG8_BAR;
#undef PG8_SA
#undef PG8_SB
#undef PG8_STAGE
#undef PG8_LDA
#undef PG8_LDB
#undef PG8_MMA
#undef PG8_WAIT_V
#undef PG8_WAIT_L
#undef PG8_BAR
#undef PG8_SCHED
}
}


struct Args { const float* in[34]; float* out; unsigned char* ws; int ph_lo, ph_hi; };

struct Frame {
    LAS unsigned char* lds; int tid, lane, wave, G, gw, NGW;
};
typedef const float* cfp_t;
typedef const __attribute__((address_space(4))) Args* KArgs;
__device__ __forceinline__ KArgs kargs() { KArgs p = (KArgs)__builtin_amdgcn_kernarg_segment_ptr(); asm volatile("" : "+s"(p)); return p; }
__device__ __forceinline__ float wave_sum(float v) {
#pragma unroll
    for (int o = 1; o < 64; o <<= 1) v += __shfl_xor(v, o);
    return v;
}

enum { EK_SWIGLU = 1, EK_RESID, EK_PLE, EK_WIN, EK_S1, EK_S2, EK_SS, EK_GLU, EK_MRG, EK_PP };
struct EpiArgs {
    unsigned char* ws; float* out;
    const float* base0; const float* base1;
    const float* dskip;
    int ssq_i, ssq_o;
    float alpha;
};
#define WSP(T, off) ((T*)(a.ws + (off)))
template <int KIND> __device__ __forceinline__ float resid8(const EpiArgs& a, int row, int col, f32x4 x0, f32x4 x1) {
    const float* bp = row < MP ? a.base0 + (size_t)row * DM : a.base1 + (size_t)(row - MP) * DM;
    const f32x4 b0 = *(const f32x4*)(bp + col), b1 = *(const f32x4*)(bp + col + 4);
    f32x4 v0, v1;
    if constexpr (KIND == EK_PLE) { const float rs = rs_of(WSP(const float, WS_SSQ)[(size_t)a.ssq_i * M + row]); f32x4 p0, p1; unpack8(*(const u32x4*)(WSP(const bf16_t, WS_PP) + (size_t)row * DM + col), p0, p1);
        v0 = b0 + sigmoid4(x0 * rs) * p0; v1 = b1 + sigmoid4(x1 * rs) * p1; }
    else { v0 = b0 + a.alpha * x0; v1 = b1 + a.alpha * x1; }
    *(f32x4*)(a.out + (size_t)row * DM + col) = v0; *(f32x4*)(a.out + (size_t)row * DM + col + 4) = v1;
    if constexpr (KIND == EK_RESID) *(u32x4*)(WSP(bf16_t, WS_XB) + (size_t)row * DM + col) = pack8(v0, v1);
    return (v0[0] * v0[0] + v0[1] * v0[1]) + (v0[2] * v0[2] + v0[3] * v0[3]) + (v1[0] * v1[0] + v1[1] * v1[1]) + (v1[2] * v1[2] + v1[3] * v1[3]);
}
template <int KIND> struct Epi {
    EpiArgs a;
    __device__ __forceinline__ void mid(f32x4 (&acc)[2][2][4][2], const pg8::Unit& u, int wr, int wc, int fr, int fq) const {
        const int c8t = wc * 32 + 8 * fq;
#pragma unroll
        for (int ai = 0; ai < 2; ++ai)
#pragma unroll
            for (int m = 0; m < 4; ++m) { const int row = u.pm * 256 + ai * 128 + wr * 64 + m * 16 + fr;
#pragma unroll
                for (int bj = 0; bj < 2; ++bj) { const int col = u.pn * 256 + bj * 128 + c8t;
                    f32x4 a0, a1, b0, b1; unpack8(*(const u32x4*)(WSP(const bf16_t, WS_SA) + (size_t)row * DM + col), a0, a1); unpack8(*(const u32x4*)(WSP(const bf16_t, WS_SB) + (size_t)row * DM + col), b0, b1);
#pragma unroll
                    for (int e = 0; e < 4; ++e) { acc[ai][bj][m][0][e] *= a0[e] * __builtin_amdgcn_rcpf(b0[e]); acc[ai][bj][m][1][e] *= a1[e] * __builtin_amdgcn_rcpf(b1[e]); } }
                asm volatile("" ::: "memory"); }
    }
    __device__ __forceinline__ void operator()(f32x4 (&acc)[2][2][4][2], const pg8::Unit& u, int wr, int wc, int fr, int fq) const {
        const int c8t = wc * 32 + 8 * fq;
#pragma unroll
        for (int ai = 0; ai < 2; ++ai)
#pragma unroll
            for (int m = 0; m < 4; ++m) {
                const int row = u.pm * 256 + ai * 128 + wr * 64 + m * 16 + fr;
                if constexpr (KIND == EK_SWIGLU) {
                    const float rs = rs_of(WSP(const float, WS_SSQ)[(size_t)a.ssq_i * M + row]);
                    const f32x4 g0 = acc[ai][0][m][0] * rs, g1 = acc[ai][0][m][1] * rs, u0 = acc[ai][1][m][0] * rs, u1 = acc[ai][1][m][1] * rs;
                    const f32x4 h0 = g0 * sigmoid4(g0) * u0, h1 = g1 * sigmoid4(g1) * u1;
                    *(u32x4*)(WSP(bf16_t, WS_HID) + (size_t)row * DFF + u.pn * 128 + c8t) = pack8(h0, h1);
                } else if constexpr (KIND == EK_RESID || KIND == EK_PLE) {
                    float sq = 0.f;
#pragma unroll
                    for (int bj = 0; bj < 2; ++bj) sq += resid8<KIND>(a, row, u.pn * 256 + bj * 128 + c8t, acc[ai][bj][m][0], acc[ai][bj][m][1]);
                    sq += __shfl_xor(sq, 16); sq += __shfl_xor(sq, 32);
                    if (fq == 0) atomicAdd(WSP(float, WS_SSQ) + (size_t)a.ssq_o * M + row, sq);
                } else if constexpr (KIND == EK_WIN) {
                    const float rs = rs_of(WSP(const float, WS_SSQ)[(size_t)a.ssq_i * M + row]);
                    const int pn = u.pn;
#pragma unroll
                    for (int bj = 0; bj < 2; ++bj) {
                        const int c8 = bj * 128 + c8t;
                        f32x4 v0 = acc[ai][bj][m][0] * rs, v1 = acc[ai][bj][m][1] * rs;
                        if (pn < 2) {
                            const int col = pn * 256 + c8, grp = col >> 4, ch0 = col & 15;
                            bf16_t* dst = row < MP ? WSP(bf16_t, WS_UGX) + ((size_t)grp * NCR + (row >> 5)) * UGP + 128 + (row & 31) * 16 + ch0
                                                   : WSP(bf16_t, WS_USX) + ((size_t)grp * 128 + ((row - MP) >> 3)) * 256 + 128 + ((row - MP) & 7) * 16 + ch0;
                            *(u32x4*)dst = pack8(v0, v1);
                        } else if (pn < 5) {
                            *(u32x4*)(WSP(bf16_t, WS_QB) + (size_t)row * 768 + (pn - 2) * 256 + c8) = pack8(v0 * QSCALE, v1 * QSCALE);
                        } else if (pn < 11) {
                            const int kvsel = pn >= 8 ? 1 : 0, gq = (pn - 5) % 3, keep = 128 << (2 * gq);
                            *(u32x4*)(WSP(bf16_t, (kvsel ? WS_VB : WS_KB)) + (size_t)row * 768 + gq * 256 + c8) = pack8(v0, v1);
                            float* fo = nullptr;
                            if (row >= MP) fo = a.out + (gq == 0 ? O_KVS0 : gq == 1 ? O_KVS1 : O_KVS2) + ((size_t)(row - MP) * 2 + kvsel) * 256 + c8;
                            else { const int b = row >> 13, t = row & (SEQ - 1); if (t >= SEQ - keep) fo = a.out + (gq == 0 ? O_KVP0 : gq == 1 ? O_KVP1 : O_KVP2) + (((size_t)b * keep + (t - (SEQ - keep))) * 2 + kvsel) * 256 + c8; }
                            if (fo) { *(f32x4*)fo = v0; *(f32x4*)(fo + 4) = v1; }
                        } else {
                            *(u32x4*)(WSP(bf16_t, (pn < 15 ? WS_SA : WS_SB)) + (size_t)row * DM + ((pn - 11) & 3) * 256 + c8) = pack8(sigmoid4(v0), sigmoid4(v1));
                        }
                    }
                } else if constexpr (KIND == EK_S1) {
                    if (u.pn == 0) { float* d = WSP(float, WS_SC) + ((size_t)u.g * NCR + row) * 128 + c8t; *(f32x4*)d = acc[ai][0][m][0]; *(f32x4*)(d + 4) = acc[ai][0][m][1]; }
                } else if constexpr (KIND == EK_S2) {
#pragma unroll
                    for (int bj = 0; bj < 2; ++bj) {
                        const int col = u.pn * 256 + bj * 128 + c8t, t = col >> 4, ch0 = col & 15;
                        f32x4 u0, u1; unpack8(*(const u32x4*)(WSP(const bf16_t, WS_UGX) + ((size_t)u.g * NCR + row) * UGP + 128 + t * 16 + ch0), u0, u1);
                        const f32x4 d0 = *(const f32x4*)(a.dskip + u.g * 16 + ch0), d1 = *(const f32x4*)(a.dskip + u.g * 16 + ch0 + 4);
                        const f32x4 y0 = gelu4(acc[ai][bj][m][0] + d0 * u0), y1 = gelu4(acc[ai][bj][m][1] + d1 * u1);
                        *(u32x4*)(WSP(bf16_t, WS_YS) + ((size_t)row * TCH + t) * DSSM + u.g * 16 + ch0) = pack8(y0, y1);
                    }
                } else if constexpr (KIND == EK_SS) {
                    if (ai == 0) {
                        const int n = row;
                        { const int col = c8t, l = col >> 4, ch0 = col & 15;
                          f32x4 u0, u1; unpack8(*(const u32x4*)(WSP(const bf16_t, WS_USX) + ((size_t)u.g * 128 + n) * 256 + 128 + l * 16 + ch0), u0, u1);
                          const f32x4 d0 = *(const f32x4*)(a.dskip + u.g * 16 + ch0), d1 = *(const f32x4*)(a.dskip + u.g * 16 + ch0 + 4);
                          const f32x4 y0 = gelu4(acc[0][0][m][0] + d0 * u0), y1 = gelu4(acc[0][0][m][1] + d1 * u1);
                          *(u32x4*)(WSP(bf16_t, WS_YS) + ((size_t)(MP + n * 8 + l)) * DSSM + u.g * 16 + ch0) = pack8(y0, y1); }
                        { float* d = a.out + O_SSMS + ((size_t)n * NG + u.g) * 128 + c8t; *(f32x4*)d = acc[0][1][m][0]; *(f32x4*)(d + 4) = acc[0][1][m][1]; }
                    }
                } else if constexpr (KIND == EK_GLU) {
#pragma unroll
                    for (int bj = 0; bj < 2; ++bj) { const int col = u.pn * 256 + bj * 128 + c8t;
                        f32x4 y0, y1; unpack8(*(const u32x4*)(WSP(const bf16_t, WS_YS) + (size_t)row * DSSM + col), y0, y1);
                        *(u32x4*)(WSP(bf16_t, WS_YGA) + (size_t)row * KMRG + col) = pack8(y0 * sigmoid4(acc[ai][bj][m][0]), y1 * sigmoid4(acc[ai][bj][m][1])); }
                } else if constexpr (KIND == EK_MRG) {
#pragma unroll
                    for (int bj = 0; bj < 2; ++bj) { const int col = u.pn * 256 + bj * 128 + c8t;
                        f32x4 s0, s1; unpack8(*(const u32x4*)(WSP(const bf16_t, WS_SB) + (size_t)row * DM + col), s0, s1);
                        *(u32x4*)(WSP(bf16_t, WS_MRG) + (size_t)row * DM + col) = pack8(s0 * acc[ai][bj][m][0], s1 * acc[ai][bj][m][1]); }
                } else if constexpr (KIND == EK_PP) {
#pragma unroll
                    for (int bj = 0; bj < 2; ++bj) { const int col = u.pn * 256 + bj * 128 + c8t;
                        *(u32x4*)(WSP(bf16_t, WS_PP) + (size_t)row * DM + col) = pack8(acc[ai][bj][m][0], acc[ai][bj][m][1]); }
                }
            }
    }
};


template <int KIND, int LDA, int LDB, int KK>
__device__ __forceinline__ void mini_gemm(Frame& F, const bf16_t* A, const bf16_t* Bt, int mu, const EpiArgs& a) {
    const int lane = F.lane, w = F.wave;
    const int r0 = MP + 64 * (mu >> 4), c0 = 64 * (mu & 15);
    f32x4 acc[4][4];
#pragma unroll
    for (int m = 0; m < 4; ++m)
#pragma unroll
        for (int n = 0; n < 4; ++n) acc[m][n] = (f32x4){0.f, 0.f, 0.f, 0.f};
    int kbeg, ksteps;
    if constexpr (KIND == EK_MRG) { if (w < 4) { kbeg = w * 128; ksteps = 4; } else { kbeg = DSSM + (w - 4) * 64; ksteps = 2; } }
    else { kbeg = w * (KK / 8); ksteps = KK / 8 / 32; }
    const bf16_t* ap = A + (size_t)(r0 + (lane & 15)) * LDA + kbeg + 8 * (lane >> 4);
    const bf16_t* bp = Bt + (size_t)(c0 + (lane & 15)) * LDB + kbeg + 8 * (lane >> 4);
#pragma unroll 2
    for (int s = 0; s < ksteps; ++s) {
        bf16x8 af[4], bfr[4];
#pragma unroll
        for (int m = 0; m < 4; ++m) af[m] = *(const bf16x8*)(ap + (size_t)16 * m * LDA + 32 * s);
#pragma unroll
        for (int n = 0; n < 4; ++n) bfr[n] = *(const bf16x8*)(bp + (size_t)16 * n * LDB + 32 * s);
#pragma unroll
        for (int m = 0; m < 4; ++m)
#pragma unroll
            for (int n = 0; n < 4; ++n) acc[m][n] = __builtin_amdgcn_mfma_f32_16x16x32_bf16(bfr[n], af[m], acc[m][n], 0, 0, 0);
    }
    __syncthreads();
    LAS float* P = (LAS float*)F.lds;
#pragma unroll
    for (int m = 0; m < 4; ++m)
#pragma unroll
        for (int n = 0; n < 4; ++n) { const int row = 16 * m + (lane & 15), chunk = 4 * n + (lane >> 4); *(LAS f32x4*)(P + w * 4096 + row * 64 + ((chunk ^ (row & 15)) << 2)) = acc[m][n]; }
    __syncthreads();
    const int row = F.tid >> 3, ch = 2 * (F.tid & 7);
    f32x4 x0 = {0.f, 0.f, 0.f, 0.f}, x1 = x0, y0 = x0, y1 = x0;
#pragma unroll
    for (int w2 = 0; w2 < 8; ++w2) { const f32x4 p0 = *(const LAS f32x4*)(P + w2 * 4096 + row * 64 + ((ch ^ (row & 15)) << 2)), p1 = *(const LAS f32x4*)(P + w2 * 4096 + row * 64 + (((ch + 1) ^ (row & 15)) << 2));
        if (KIND == EK_MRG && w2 >= 4) { y0 += p0; y1 += p1; } else { x0 += p0; x1 += p1; } }
    const int grow = r0 + row, gcol = c0 + 8 * (F.tid & 7);
    if constexpr (KIND == EK_MRG) {
        f32x4 a0, a1, b0, b1; unpack8(*(const u32x4*)(WSP(const bf16_t, WS_SA) + (size_t)grow * DM + gcol), a0, a1); unpack8(*(const u32x4*)(WSP(const bf16_t, WS_SB) + (size_t)grow * DM + gcol), b0, b1);
        *(u32x4*)(WSP(bf16_t, WS_MRG) + (size_t)grow * DM + gcol) = pack8(a0 * x0 + b0 * y0, a1 * x1 + b1 * y1);
    } else {
        float sq = resid8<KIND>(a, grow, gcol, x0, x1);
        sq += __shfl_xor(sq, 1); sq += __shfl_xor(sq, 2); sq += __shfl_xor(sq, 4);
        if ((F.tid & 7) == 0) atomicAdd(WSP(float, WS_SSQ) + (size_t)a.ssq_o * M + grow, sq);
    }
    __syncthreads();
}

#define DEFCFG(NAME, KIND_, LDA_, LDB_, KK_, NM_, NN_, NGRP_, GSA_, GSB_) struct NAME { static constexpr int KIND = KIND_, LDA = LDA_, LDB = LDB_, KK = KK_, NM = NM_, NN = NN_, NGRP = NGRP_, UPC = 0, MIDT = 0; static constexpr long GSA = GSA_, GSB = GSB_; }
DEFCFG(CfgGU,   EK_SWIGLU, DM,   DM,   DM,   M / 256, 22, 1, 0, 0);
DEFCFG(CfgPP,   EK_PP,     DPLE, DPLE, DPLE, M / 256, 4,  1, 0, 0);
DEFCFG(CfgDown, EK_RESID,  DFF,  DFF,  DFF,  MP / 256, 4, 1, 0, 0);
DEFCFG(CfgWin,  EK_WIN,    DM,   DM,   DM,   M / 256, 19, 1, 0, 0);
DEFCFG(CfgS1,   EK_S1,     UGP,  512,  512,  2, 1, NG, (long)NCR * UGP, 256L * 512);
DEFCFG(CfgSS,   EK_SS,     256,  256,  256,  1, 1, NG, 128L * 256, 256L * 256);
struct CfgS2 { static constexpr int KIND = EK_S2, LDA = UGP, LDB = UGP, KK = UGP, NM = 2, NN = 2, NGRP = NG, UPC = 1, MIDT = 0; static constexpr long GSA = (long)NCR * UGP, GSB = 512L * UGP; };
DEFCFG(CfgGLU,  EK_GLU,    DSSM, DSSM, DSSM, M / 256, 2,  1, 0, 0);
struct CfgMrg { static constexpr int KIND = EK_MRG, LDA = KMRG, LDB = KMRG, KK = KMRG, NM = MP / 256, NN = 4, NGRP = 1, UPC = 0, MIDT = 8; static constexpr long GSA = 0, GSB = 0; };
DEFCFG(CfgOut,  EK_RESID,  DM,   DM,   DM,   MP / 256, 4, 1, 0, 0);
DEFCFG(CfgPle,  EK_PLE,    DM,   DM,   DM,   MP / 256, 4, 1, 0, 0);

typedef GAS unsigned gu32;
#define RLX_AGENT __ATOMIC_RELAXED, __HIP_MEMORY_SCOPE_AGENT
#define XB_TMO      128
#define XB_XCNT(j)  (256  + 64 * (j))
#define XB_XSUB(j)  (1280 + 64 * (j))
#define XB_XGEN(j)  (2304 + 64 * (j))
#define XB_TOP      3328
#define XB_TOPGEN   3392
#define XCD_BAR_WORDS 3456
#define XB_SPIN_CAP (1u << 18)
__device__ __forceinline__ unsigned xb_ld(unsigned* p)              { return __hip_atomic_load(p, __ATOMIC_RELAXED, __HIP_MEMORY_SCOPE_AGENT); }
__device__ __forceinline__ unsigned xb_add(unsigned* p, unsigned v) { return __hip_atomic_fetch_add(p, v, __ATOMIC_RELAXED, __HIP_MEMORY_SCOPE_AGENT); }
__device__ __forceinline__ unsigned xb_xcc_id() { return (unsigned)__builtin_amdgcn_s_getreg((3 << 11) | 20) & 0xFu; }
#define XB_SPIN(cond, bar) do { unsigned _sp = 0; while (cond) { __builtin_amdgcn_s_sleep(1); \
    if ((++_sp & 255u) == 0u) { if (xb_ld(&(bar)[XB_TMO])) break; if (_sp > XB_SPIN_CAP) { atomicAdd(&(bar)[XB_TMO], 1u); break; } } } } while (0)
struct XcdBarrier { unsigned* bar; unsigned x; volatile LAS unsigned* st; };
__device__ __forceinline__ XcdBarrier xcd_barrier_post(unsigned* bar, volatile LAS unsigned* st) {
    XcdBarrier b; b.bar = bar; b.x = xb_xcc_id(); b.st = st;
    if (threadIdx.x == 0) (void)xb_add(&bar[XB_XCNT(b.x)], 1u);
    return b;
}
__device__ __forceinline__ void xcd_barrier_complete(unsigned* bar, unsigned x, unsigned& nloc, unsigned& nx) {
    const unsigned G = gridDim.x * gridDim.y * gridDim.z;
    unsigned sum, cnt, mine, sp = 0u;
    for (;;) {
        sum = 0u; cnt = 0u; mine = 0u;
#pragma unroll
        for (unsigned j = 0; j < 16; ++j) { const unsigned c = xb_ld(&bar[XB_XCNT(j)]); sum += c; cnt += (c > 0u) ? 1u : 0u; mine = (j == x) ? c : mine; }
        if (sum == G) break;
        __builtin_amdgcn_s_sleep(1);
        if ((++sp & 255u) == 0u) { if (xb_ld(&bar[XB_TMO])) break; if (sp > XB_SPIN_CAP) { atomicAdd(&bar[XB_TMO], 1u); break; } }
    }
    nloc = mine > 0u ? mine : 1u; nx = cnt > 0u ? cnt : 1u;
}
__device__ __forceinline__ void xcd_barrier(const XcdBarrier& b) {
    asm volatile("s_waitcnt vmcnt(0)" ::: "memory");
    __syncthreads();
    if (threadIdx.x == 0) {
        unsigned* bar = b.bar;
        __builtin_amdgcn_s_waitcnt(0);
        unsigned nloc = b.st[0], nx = b.st[1];
        if (nloc == 0u) { xcd_barrier_complete(bar, b.x, nloc, nx); b.st[0] = nloc; b.st[1] = nx; }
        const unsigned old = xb_add(&bar[XB_XSUB(b.x)], 1u);
        const unsigned gen = old / nloc;
        if (old + 1u == (gen + 1u) * nloc) {
            __builtin_amdgcn_fence(__ATOMIC_RELEASE, "agent");
            asm volatile("s_waitcnt vmcnt(0)" ::: "memory");
            const unsigned og = xb_add(&bar[XB_TOP], 1u);
            const unsigned tg = og / nx;
            if (og + 1u == (tg + 1u) * nx) xb_add(&bar[XB_TOPGEN], 1u);
            else XB_SPIN(xb_ld(&bar[XB_TOPGEN]) == tg, bar);
            __builtin_amdgcn_fence(__ATOMIC_ACQUIRE, "agent");
            xb_add(&bar[XB_XGEN(b.x)], 1u);
            asm volatile("s_waitcnt vmcnt(0)" ::: "memory");
        } else {
            XB_SPIN(xb_ld(&bar[XB_XGEN(b.x)]) == gen, bar);
            __builtin_amdgcn_fence(__ATOMIC_ACQUIRE, "agent");
            asm volatile("s_waitcnt vmcnt(0)" ::: "memory");
        }
    }
    __syncthreads();
}

__device__ __forceinline__ void p0_transpose_item(const float* W, int N, bf16_t* WT, int ldt, int k0, int n0, int dst_row0, const float* gk, LAS float* scr, int lane) {
    f32x4 v[16];
#pragma unroll
    for (int i = 0; i < 16; ++i) { const int kk = 4 * i + (lane >> 4); v[i] = *(const f32x4*)(W + (size_t)(k0 + kk) * N + n0 + 4 * (lane & 15)); }
    if (gk) {
#pragma unroll
        for (int i = 0; i < 16; ++i) v[i] = v[i] * gk[k0 + 4 * i + (lane >> 4)]; }
#pragma unroll
    for (int i = 0; i < 16; ++i) { const int kk = 4 * i + (lane >> 4); *(LAS f32x4*)(scr + kk * 64 + ((4 * (lane & 15)) ^ (((kk >> 3) & 7) << 2))) = v[i]; }
    LDS_WAIT(); asm volatile("" ::: "memory");
    const int c = lane & 7;
#pragma unroll
    for (int j = 0; j < 8; ++j) { const int n = (lane >> 3) + 8 * j; const LAS float* s = scr + (8 * c) * 64 + (n ^ (c << 2));
        u32x4 o; o.x = cvtpk(s[0 * 64], s[1 * 64]); o.y = cvtpk(s[2 * 64], s[3 * 64]); o.z = cvtpk(s[4 * 64], s[5 * 64]); o.w = cvtpk(s[6 * 64], s[7 * 64]);
        *(u32x4*)(WT + (size_t)(dst_row0 + n) * ldt + k0 + 8 * c) = o; }
    LDS_WAIT(); asm volatile("" ::: "memory");
}
struct WJob { const float* W; int K, N; bf16_t* WT; const float* gk; int mode; int ldt, koff; };
__device__ __forceinline__ void p0_wjob(const WJob& j, int item, LAS float* scr, int lane) {
    const int nblk = j.N / 64, kb = item / nblk, nb = item % nblk, n0 = 64 * nb;
    const int dst = j.mode == 0 ? n0 : (n0 / 128) * 256 + (n0 % 128) + (j.mode == 2 ? 128 : 0);
    p0_transpose_item(j.W, j.N, j.WT + j.koff, j.ldt, 64 * kb, n0, dst, j.gk, scr, lane);
}

__device__ __forceinline__ double dexp(double x) {
    const double k = __builtin_rint(x * 1.4426950408889634074), r = __builtin_fma(-k, 6.93147180369123816490e-01, x) - k * 1.90821492927058770002e-10;
    double p = 1.0 / 479001600.0;
    p = p * r + 1.0 / 39916800.0; p = p * r + 1.0 / 3628800.0; p = p * r + 1.0 / 362880.0; p = p * r + 1.0 / 40320.0; p = p * r + 1.0 / 5040.0; p = p * r + 1.0 / 720.0;
    p = p * r + 1.0 / 120.0; p = p * r + 1.0 / 24.0; p = p * r + 1.0 / 6.0; p = p * r + 0.5; p = p * r + 1.0; p = p * r + 1.0;
    return __builtin_ldexp(p, (int)k);
}
__device__ __forceinline__ void dsincos(double a, double& s, double& c) {
    const double k = __builtin_rint(a * 0.63661977236758134308);
    double r = __builtin_fma(-k, 1.57079632673412561417e+00, a); r = __builtin_fma(-k, 6.07710050650619224932e-11, r);
    const double z = r * r;
    double sp = -1.0 / 1307674368000.0; sp = sp * z + 1.0 / 6227020800.0; sp = sp * z - 1.0 / 39916800.0; sp = sp * z + 1.0 / 362880.0; sp = sp * z - 1.0 / 5040.0; sp = sp * z + 1.0 / 120.0; sp = sp * z - 1.0 / 6.0; sp = sp * z * r + r;
    double cp = 1.0 / 20922789888000.0; cp = cp * z - 1.0 / 87178291200.0; cp = cp * z + 1.0 / 479001600.0; cp = cp * z - 1.0 / 3628800.0; cp = cp * z + 1.0 / 40320.0; cp = cp * z - 1.0 / 720.0; cp = cp * z + 1.0 / 24.0; cp = cp * z - 0.5; cp = cp * z + 1.0;
    const int q = ((int)k) & 3;
    s = (q == 0) ? sp : (q == 1) ? cp : (q == 2) ? -sp : -cp;
    c = (q == 0) ? cp : (q == 1) ? -sp : (q == 2) ? -cp : sp;
}
__device__ __forceinline__ void cpow_d(double are, double aim, double dt, int n, double& pr, double& pi) {
    const double mag = dexp((double)n * are * dt); double s, c; dsincos((double)n * aim * dt, s, c); pr = mag * c; pi = mag * s;
}
__device__ __forceinline__ void ffac_d(double are, double aim, double dt, double& fr, double& fi) {
    double er, ei; cpow_d(are, aim, dt, 1, er, ei);
    const double nr = er - 1.0, ni = ei, den = are * are + aim * aim;
    fr = (nr * are + ni * aim) / den; fi = (ni * are - nr * aim) / den;
}

__device__ __forceinline__ void phase_prologue(Frame& F) {
    KArgs ka = kargs(); const __attribute__((address_space(4))) cfp_t* in = ka->in; unsigned char* ws = ka->ws;
    LAS float* scr = (LAS float*)(F.lds + F.wave * 16384);
    int it = F.gw;
#define DOJOB(W_, K_, N_, WT_, GK_, MODE_) DOJOB2(W_, K_, N_, WT_, GK_, MODE_, K_, 0)
#define DOJOB2(W_, K_, N_, WT_, GK_, MODE_, LDT_, KOFF_) do { const WJob jb{W_, K_, N_, (bf16_t*)(ws + WT_), GK_, MODE_, LDT_, KOFF_}; const int n_items = ((K_) / 64) * ((N_) / 64); \
        for (; it < n_items; it += F.NGW) p0_wjob(jb, it, scr, F.lane); it -= n_items; } while (0)
    DOJOB(in[9], DM, DFF, WS_W1GU, in[8], 1); DOJOB(in[10], DM, DFF, WS_W1GU, in[8], 2); DOJOB(in[11], DFF, DM, WS_W1D, nullptr, 0);
    DOJOB(in[13], DM, DIN, WS_WIN, in[12], 0); DOJOB(in[22], DSSM, DSSM, WS_WGLU, nullptr, 0); DOJOB2(in[23], DSSM, DM, WS_WBS, nullptr, 0, KMRG, 0);
    DOJOB2(in[24], 256, DM, WS_WBS, nullptr, 0, KMRG, DSSM); DOJOB(in[25], DM, DM, WS_WOUT, nullptr, 0);
    DOJOB(in[27], DM, DFF, WS_W2GU, in[26], 1); DOJOB(in[28], DM, DFF, WS_W2GU, in[26], 2); DOJOB(in[29], DFF, DM, WS_W2D, nullptr, 0);
    DOJOB(in[31], DM, DM, WS_WPG, in[30], 0); DOJOB(in[32], DPLE, DM, WS_WPP, nullptr, 0);
#undef DOJOB
#undef DOJOB2
    float* ssq0 = (float*)(ws + WS_SSQ);
    bf16_t* XB = (bf16_t*)(ws + WS_XB); bf16_t* PB = (bf16_t*)(ws + WS_PB);
    for (int m = F.gw; m < M; m += F.NGW) {
        const float* xr = m < MP ? in[0] + (size_t)m * DM : in[1] + (size_t)(m - MP) * DM;
        f32x4 v[4]; float s = 0.f;
#pragma unroll
        for (int j = 0; j < 4; ++j) { v[j] = ((const f32x4*)xr)[F.lane + 64 * j]; s += (v[j][0] * v[j][0] + v[j][1] * v[j][1]) + (v[j][2] * v[j][2] + v[j][3] * v[j][3]); }
        s = wave_sum(s);
        if (F.lane == 0) ssq0[m] = s;
#pragma unroll
        for (int j = 0; j < 4; ++j) { u32x2 w; w.x = cvtpk(v[j][0], v[j][1]); w.y = cvtpk(v[j][2], v[j][3]); ((u32x2*)(XB + (size_t)m * DM))[F.lane + 64 * j] = w; }
        const float* pr = m < MP ? in[2] + (size_t)m * DPLE : in[3] + (size_t)(m - MP) * DPLE;
        const f32x4 pv = ((const f32x4*)pr)[F.lane]; u32x2 w; w.x = cvtpk(pv[0], pv[1]); w.y = cvtpk(pv[2], pv[3]); ((u32x2*)(PB + (size_t)m * DPLE))[F.lane] = w;
    }
    bf16_t* USX = (bf16_t*)(ws + WS_USX);
    for (int i = F.gw; i < NSB * NG; i += F.NGW) { const int n = i / NG, g = i % NG;
        if (F.lane < 32) { const f32x4 v = ((const f32x4*)(in[7] + ((size_t)n * NG + g) * 128))[F.lane]; u32x2 w; w.x = cvtpk(v[0], v[1]); w.y = cvtpk(v[2], v[3]);
            ((u32x2*)(USX + ((size_t)g * 128 + n) * 256))[F.lane] = w; } }
    float* POW = (float*)(ws + WS_POW); float* BBAR = (float*)(ws + WS_BBAR);
    const int gt = F.gw * 64 + F.lane, NT = F.NGW * 64;
    for (int i = gt; i < NG * NP * 33 + NG * NP; i += NT) {
        if (i < NG * NP * 33) { const int gp = i / 33, n = i % 33, g = gp / NP;
            const double are = in[14][gp], aim = in[15][gp], dt = dexp((double)in[16][g]); double pr, pi; cpow_d(are, aim, dt, n, pr, pi);
            POW[(size_t)i * 2] = (float)pr; POW[(size_t)i * 2 + 1] = (float)pi;
        } else { const int gp = i - NG * NP * 33, g = gp / NP;
            const double are = in[14][gp], aim = in[15][gp], dt = dexp((double)in[16][g]); double fr, fi; ffac_d(are, aim, dt, fr, fi);
#pragma unroll 4
            for (int c = 0; c < 16; ++c) { const double br = in[17][gp * 16 + c], bi = in[18][gp * 16 + c];
                BBAR[((size_t)gp * 16 + c) * 2] = (float)(fr * br - fi * bi); BBAR[((size_t)gp * 16 + c) * 2 + 1] = (float)(fr * bi + fi * br); }
        }
    }
}

__device__ __forceinline__ void phase_build_ssm(Frame& F, int part) {
    KArgs ka = kargs(); const __attribute__((address_space(4))) cfp_t* in = ka->in; unsigned char* ws = ka->ws;
    const float* POW = (const float*)(ws + WS_POW); const float* BBAR = (const float*)(ws + WS_BBAR); float* KTAB = (float*)(ws + WS_KTAB);
    bf16_t* WM = (bf16_t*)(ws + WS_WM); bf16_t* B2 = (bf16_t*)(ws + WS_B2); bf16_t* BS = (bf16_t*)(ws + WS_BS);
    const int gt = F.gw * 64 + F.lane, NT = F.NGW * 64;
    if (part == 1) {
        for (int i = gt; i < NG * TCH * 256; i += NT) {
            const int g = i / (TCH * 256), tau = (i / 256) % TCH, c = (i >> 4) & 15, c2 = i & 15; float s = 0.f;
#pragma unroll 8
            for (int p = 0; p < NP; ++p) { const f32x2 pw = *(const f32x2*)(POW + ((size_t)(g * NP + p) * 33 + tau) * 2), bb = *(const f32x2*)(BBAR + ((size_t)(g * NP + p) * 16 + c2) * 2);
                const float zr = pw.x * bb.x - pw.y * bb.y, zi = pw.x * bb.y + pw.y * bb.x; s += in[19][(g * 16 + c) * NP + p] * zr - in[20][(g * 16 + c) * NP + p] * zi; }
            KTAB[i] = s;
        }
        constexpr int N_WM = NG * 256 * 64, N_B2 = NG * 512 * 16, N_BS = NG * 128 * 16 + NG * 128 * 32;
        for (int i = gt; i < N_WM + N_B2 + N_BS; i += NT) {
            float v[8]; bf16_t* dst;
            if (i < N_WM) {
                const int g = i / (256 * 64), r = i % (256 * 64), n = r / 64, k8 = (r % 64) * 8; dst = WM + ((size_t)g * 256 + n) * 512 + k8;
                if (n < 128) { const int p = n >> 1, ri = n & 1, s = k8 >> 4, c0 = k8 & 15; const float pr = POW[((size_t)(g * NP + p) * 33 + (31 - s)) * 2], pi = POW[((size_t)(g * NP + p) * 33 + (31 - s)) * 2 + 1];
#pragma unroll
                    for (int j = 0; j < 8; ++j) { const float br = BBAR[((size_t)(g * NP + p) * 16 + c0 + j) * 2], bi = BBAR[((size_t)(g * NP + p) * 16 + c0 + j) * 2 + 1]; v[j] = ri ? pr * bi + pi * br : pr * br - pi * bi; } }
                else {
#pragma unroll
                    for (int j = 0; j < 8; ++j) v[j] = 0.f; }
            } else {
                int g, t, c, k8; bool carry;
                const int i2 = i - N_WM;
                if (i2 < N_B2) { g = i2 / (512 * 16); const int r = i2 % (512 * 16), row = r / 16; k8 = (r % 16) * 8; t = row >> 4; c = row & 15; dst = B2 + ((size_t)g * 512 + row) * UGP + k8; carry = true; }
                else { const int i3 = i2 - N_B2;
                    if (i3 < NG * 128 * 16) { g = i3 / (128 * 16); const int r = i3 % (128 * 16), row = r / 16; k8 = (r % 16) * 8; t = row >> 4; c = row & 15; dst = BS + ((size_t)g * 256 + row) * 256 + k8; carry = true; }
                    else { const int i4 = i3 - NG * 128 * 16; g = i4 / (128 * 32); const int r = i4 % (128 * 32), row = 128 + r / 32; k8 = (r % 32) * 8; t = row; c = 0; dst = BS + ((size_t)g * 256 + row) * 256 + k8; carry = false; } }
                if (carry) {
#pragma unroll
                    for (int jj = 0; jj < 4; ++jj) { const int p = (k8 >> 1) + jj; const float pr = POW[((size_t)(g * NP + p) * 33 + (t + 1)) * 2], pi = POW[((size_t)(g * NP + p) * 33 + (t + 1)) * 2 + 1];
                        const float cr = in[19][(g * 16 + c) * NP + p], ci = in[20][(g * 16 + c) * NP + p]; v[2 * jj] = cr * pr - ci * pi; v[2 * jj + 1] = -(cr * pi + ci * pr); }
                } else { const int row = t, p = (row - 128) >> 1, ri = row & 1;
                    if (k8 < 128) { const float ar = POW[((size_t)(g * NP + p) * 33 + 8) * 2], ai = POW[((size_t)(g * NP + p) * 33 + 8) * 2 + 1];
#pragma unroll
                        for (int j = 0; j < 8; ++j) { const int p2 = (k8 + j) >> 1, ri2 = (k8 + j) & 1; v[j] = p2 != p ? 0.f : (ri == 0 ? (ri2 == 0 ? ar : -ai) : (ri2 == 0 ? ai : ar)); }
                    } else { const int s = (k8 - 128) >> 4, c0 = (k8 - 128) & 15; const float pr = POW[((size_t)(g * NP + p) * 33 + (7 - s)) * 2], pi = POW[((size_t)(g * NP + p) * 33 + (7 - s)) * 2 + 1];
#pragma unroll
                        for (int j = 0; j < 8; ++j) { const float br = BBAR[((size_t)(g * NP + p) * 16 + c0 + j) * 2], bi = BBAR[((size_t)(g * NP + p) * 16 + c0 + j) * 2 + 1]; v[j] = ri ? pr * bi + pi * br : pr * br - pi * bi; } }
                }
            }
            u32x4 w; w.x = cvtpk(v[0], v[1]); w.y = cvtpk(v[2], v[3]); w.z = cvtpk(v[4], v[5]); w.w = cvtpk(v[6], v[7]);
            *(u32x4*)dst = w;
        }
    } else {
        constexpr int N_B2 = NG * 512 * 64, N_BS = NG * 128 * 16;
        for (int i = gt; i < N_B2 + N_BS; i += NT) {
            int g, t, c, k8; bf16_t* dst;
            if (i < N_B2) { g = i / (512 * 64); const int r = i % (512 * 64), row = r / 64; k8 = (r % 64) * 8; t = row >> 4; c = row & 15; dst = B2 + ((size_t)g * 512 + row) * UGP + 128 + k8; }
            else { const int i2 = i - N_B2; g = i2 / (128 * 16); const int r = i2 % (128 * 16), row = r / 16; k8 = (r % 16) * 8; t = row >> 4; c = row & 15; dst = BS + ((size_t)g * 256 + row) * 256 + 128 + k8; }
            const int s = k8 >> 4, c0 = k8 & 15;
            u32x4 w = {0u, 0u, 0u, 0u};
            if (s <= t) { const f32x4 a = *(const f32x4*)(KTAB + ((size_t)(g * TCH + (t - s)) * 16 + c) * 16 + c0), b = *(const f32x4*)(KTAB + ((size_t)(g * TCH + (t - s)) * 16 + c) * 16 + c0 + 4); w = pack8(a, b); }
            *(u32x4*)dst = w;
        }
    }
}

constexpr int VROWB = 144, KIMG_OFF = 0, VIMG_OFF = 384 * 128, XSLOT_OFF = 8 * 16384 - 12288;
__device__ __forceinline__ s16x4 vtr(LAS const unsigned char* p) { return __builtin_bit_cast(s16x4, __builtin_amdgcn_ds_read_tr16_b64_v4i16((LAS s16x4*)p)); }
__device__ __forceinline__ void attn_prompt_unit(const bf16_t* QB, const bf16_t* KB, const bf16_t* VB, bf16_t* OG, float* LSE, int b, int g, int r, int h, int qb, LAS unsigned char* lds, int tid) {
    const int lane = tid & 63, wave = __builtin_amdgcn_readfirstlane(tid >> 6);
    const int r32 = lane & 31, hi = lane >> 5, d = 1 << (2 * g), P0 = qb * 256, m0 = P0 + 32 * wave;
    const long tok0 = (long)b * SEQ + r;
    const size_t coff = (size_t)g * 256 + h * 64;
    u32x4 kreg[6], vreg[6];
#pragma unroll
    for (int i = 0; i < 6; ++i) { const int idx = tid + 512 * i, row = idx >> 3, ch = idx & 7, pos = P0 - 128 + row;
        if (pos >= 0) { const size_t go = (size_t)(tok0 + (long)d * pos) * 768 + coff + ch * 8; kreg[i] = *(const u32x4*)(KB + go); vreg[i] = *(const u32x4*)(VB + go); }
        else { kreg[i] = (u32x4){0u, 0u, 0u, 0u}; vreg[i] = kreg[i]; } }
    const bf16_t* qrow = QB + (size_t)(tok0 + (long)d * (m0 + r32)) * 768 + coff;
    bf16x8 qf[4];
#pragma unroll
    for (int ks = 0; ks < 4; ++ks) qf[ks] = *(const bf16x8*)(qrow + 16 * ks + 8 * hi);
#pragma unroll
    for (int i = 0; i < 6; ++i) { const int idx = tid + 512 * i, row = idx >> 3, ch = idx & 7;
        *(LAS u32x4*)(lds + KIMG_OFF + row * 128 + ((ch ^ (row & 7)) << 4)) = kreg[i];
        *(LAS u32x4*)(lds + VIMG_OFF + row * VROWB + ch * 16) = vreg[i]; }
    __syncthreads();
    float m_run = -1e30f, l_run = 0.f; f32x16 o0 = {}, o1 = {};
    const int trq = (lane & 15) >> 2, trp = lane & 3, trc = 16 * ((lane >> 4) & 1) + 4 * trp;
#pragma unroll 1
    for (int kt = 4; kt >= 0; --kt) {
        const int kp0 = m0 - 128 + 32 * kt; if (kp0 < 0) continue;
        const int kr0 = 32 * (wave + kt);
        const int krow = kr0 + r32;
        f32x16 s = {};
#pragma unroll
        for (int ks = 0; ks < 4; ++ks) { const bf16x8 kf = *(const LAS bf16x8*)(lds + KIMG_OFF + krow * 128 + (((2 * ks + hi) ^ (krow & 7)) << 4)); s = __builtin_amdgcn_mfma_f32_32x32x16_bf16(kf, qf[ks], s, 0, 0, 0); }
        float mx = -1e30f;
#pragma unroll
        for (int rr = 0; rr < 16; ++rr) { const int kk = (rr & 3) + 8 * (rr >> 2) + 4 * hi;
            if ((kt == 0 && kk < r32) || (kt == 4 && kk > r32)) s[rr] = -1e30f;
            mx = fmaxf(mx, s[rr]); }
        mx = fmaxf(mx, __shfl_xor(mx, 32));
        const float m_new = fmaxf(m_run, mx), alpha = __builtin_amdgcn_exp2f(m_run - m_new);
        float rsum = 0.f;
#pragma unroll
        for (int rr = 0; rr < 16; ++rr) { s[rr] = __builtin_amdgcn_exp2f(s[rr] - m_new); rsum += s[rr]; }
        rsum += __shfl_xor(rsum, 32);
        l_run = l_run * alpha + rsum; m_run = m_new;
#pragma unroll
        for (int rr = 0; rr < 16; ++rr) { o0[rr] *= alpha; o1[rr] *= alpha; }
        bf16x8 pf[2];
#pragma unroll
        for (int s2 = 0; s2 < 2; ++s2) { u32x4 w; w.x = cvtpk(s[8 * s2], s[8 * s2 + 1]); w.y = cvtpk(s[8 * s2 + 2], s[8 * s2 + 3]); w.z = cvtpk(s[8 * s2 + 4], s[8 * s2 + 5]); w.w = cvtpk(s[8 * s2 + 6], s[8 * s2 + 7]); pf[s2] = __builtin_bit_cast(bf16x8, w); }
#pragma unroll
        for (int s2 = 0; s2 < 2; ++s2) {
#pragma unroll
            for (int dt = 0; dt < 2; ++dt) {
                const int kb = kr0 + 16 * s2 + 4 * hi + trq;
                const s16x4 lo = vtr(lds + VIMG_OFF + kb * VROWB + (32 * dt + trc) * 2), hi4 = vtr(lds + VIMG_OFF + (kb + 8) * VROWB + (32 * dt + trc) * 2);
                const bf16x8 vf = (bf16x8){lo[0], lo[1], lo[2], lo[3], hi4[0], hi4[1], hi4[2], hi4[3]};
                if (dt == 0) o0 = __builtin_amdgcn_mfma_f32_32x32x16_bf16(vf, pf[s2], o0, 0, 0, 0); else o1 = __builtin_amdgcn_mfma_f32_32x32x16_bf16(vf, pf[s2], o1, 0, 0, 0);
            }
        }
    }
    const float inv = 1.f / l_run;
    const size_t tok = (size_t)(tok0 + (long)d * (m0 + r32));
    bf16_t* orow = OG + ((size_t)g * M + tok) * 256 + h * 64;
#pragma unroll
    for (int rq = 0; rq < 4; ++rq) {
        u32x2 w0, w1; w0.x = cvtpk(o0[4 * rq] * inv, o0[4 * rq + 1] * inv); w0.y = cvtpk(o0[4 * rq + 2] * inv, o0[4 * rq + 3] * inv);
        w1.x = cvtpk(o1[4 * rq] * inv, o1[4 * rq + 1] * inv); w1.y = cvtpk(o1[4 * rq + 2] * inv, o1[4 * rq + 3] * inv);
        *(u32x2*)(orow + 8 * rq + 4 * hi) = w0; *(u32x2*)(orow + 32 + 8 * rq + 4 * hi) = w1;
    }
    if (hi == 0) LSE[((size_t)g * M + tok) * 4 + h] = m_run + __builtin_amdgcn_logf(l_run);
    __syncthreads();
}

template <int CTRL> __device__ __forceinline__ float dpp_add(float v) { return v + __int_as_float(__builtin_amdgcn_update_dpp(0, __float_as_int(v), CTRL, 0xf, 0xf, true)); }
__device__ __forceinline__ float row16_sum(float v) { v = dpp_add<0xB1>(v); v = dpp_add<0x4E>(v); v = dpp_add<0x141>(v); v = dpp_add<0x140>(v); return v; }
template <int NPARTS>
__device__ __forceinline__ void attn_sample_unit(const bf16_t* QB, const float* cache, const float* knew, bf16_t* OG, float* LSE, int n, int g, int l, int lidx, int part, LAS float* xl, int lane) {
    constexpr int LW = 8 / NPARTS;
    const int d = 1 << (2 * g), wb = 128 << (2 * g), row = MP + n * NSL + l;
    const u32x2 qw = *(const u32x2*)(QB + (size_t)row * 768 + g * 256 + lane * 4);
    const f32x4 q = {bflo(qw.x), bfhi(qw.x), bflo(qw.y), bfhi(qw.y)};
    const float* cb = cache + (size_t)n * wb * 512 + lane * 4;
    const float* nb = knew + (size_t)(n * NSL) * 512 + lane * 4;
    float m_run = -1e30f, l_run = 0.f; f32x4 o = {0.f, 0.f, 0.f, 0.f};
    const int ibeg = NPARTS == 4 ? (part == 0 ? 0 : 1 + 32 * part) : (part ? 65 : 0), iend = NPARTS == 4 ? 33 + 32 * part : (part ? 129 : 65);
#pragma unroll 1
    for (int i0 = ibeg; i0 < iend; i0 += 8) {
        f32x4 kx[8], vx[8]; float sc[8];
#pragma unroll
        for (int j = 0; j < 8; ++j) { const int i = i0 + j; const int ridx = wb + l - d * (i < iend ? i : iend - 1);
            const float* p = ridx >= wb ? nb + (size_t)(ridx - wb) * 512 : cb + (size_t)ridx * 512;
            kx[j] = *(const f32x4*)p; vx[j] = *(const f32x4*)(p + 256); }
        float mx = -1e30f;
#pragma unroll
        for (int j = 0; j < 8; ++j) { float s = (q[0] * kx[j][0] + q[1] * kx[j][1]) + (q[2] * kx[j][2] + q[3] * kx[j][3]); s = row16_sum(s); if (i0 + j >= iend) s = -1e30f; sc[j] = s; mx = fmaxf(mx, s); }
        const float m_new = fmaxf(m_run, mx), alpha = __builtin_amdgcn_exp2f(m_run - m_new);
        l_run *= alpha; o = o * alpha; m_run = m_new;
#pragma unroll
        for (int j = 0; j < 8; ++j) { const float p = __builtin_amdgcn_exp2f(sc[j] - m_new); l_run += p; o += p * vx[j]; }
    }
    if (part) { LAS float* slot = xl + (((part - 1) * LW + lidx) * 64 + lane) * 8; slot[0] = m_run; slot[1] = l_run; *(LAS f32x4*)(slot + 4) = o; }
    __syncthreads();
    if (!part) {
#pragma unroll
        for (int k2 = 0; k2 < NPARTS - 1; ++k2) { const LAS float* slot = xl + ((k2 * LW + lidx) * 64 + lane) * 8;
            const float m2 = slot[0], l2 = slot[1]; const f32x4 o2 = *(const LAS f32x4*)(slot + 4);
            const float mn = fmaxf(m_run, m2), a1 = __builtin_amdgcn_exp2f(m_run - mn), a2 = __builtin_amdgcn_exp2f(m2 - mn);
            l_run = l_run * a1 + l2 * a2; o = o * a1 + o2 * a2; m_run = mn; }
        const float inv = 1.f / l_run;
        u32x2 w; w.x = cvtpk(o[0] * inv, o[1] * inv); w.y = cvtpk(o[2] * inv, o[3] * inv);
        *(u32x2*)(OG + ((size_t)g * M + row) * 256 + lane * 4) = w;
        if ((lane & 15) == 0) LSE[((size_t)g * M + row) * 4 + (lane >> 4)] = m_run + __builtin_amdgcn_logf(l_run);
    }
}

constexpr int N_ATT_HALF = 1024, CW_TICK = 8192;
__device__ __forceinline__ void phase_attention(Frame& F, int h) {
    KArgs ka = kargs(); unsigned char* ws = ka->ws;
    const bf16_t* QB = (const bf16_t*)(ws + WS_QB); const bf16_t* KB = (const bf16_t*)(ws + WS_KB); const bf16_t* VB = (const bf16_t*)(ws + WS_VB);
    bf16_t* OG = (bf16_t*)(ws + WS_OG); float* LSE = (float*)(ws + WS_LSE);
    unsigned* ctr = (unsigned*)(ws + WS_CTL) + CW_TICK + 64 * h;
    volatile LAS unsigned* tk = (volatile LAS unsigned*)(F.lds + MISC_OFF + 64);
    LAS float* xl = (LAS float*)(F.lds + XSLOT_OFF);
    if (F.tid == 0) tk[0] = __hip_atomic_fetch_add(ctr, 1u, __ATOMIC_RELAXED, __HIP_MEMORY_SCOPE_AGENT);
    for (;;) {
        __syncthreads();
        const int j = (int)tk[0];
        __syncthreads();
        if (j >= N_ATT_HALF) break;
        unsigned nxt_ = 0; if (F.tid == 0) nxt_ = __hip_atomic_fetch_add(ctr, 1u, __ATOMIC_RELAXED, __HIP_MEMORY_SCOPE_AGENT);
        int g = -1, uidx;
        if (j < 768) { const int blk = j / 3, r = j % 3; uidx = blk; if (r == 0) g = 2; else if (r == 1) g = 1; }
        else { const int j2 = j - 768, blk = j2 >> 1; if ((j2 & 1) == 0) { g = 0; uidx = blk; } else uidx = 256 + blk; }
        if (g >= 0) {
            const float* cache = g == 0 ? ka->in[4] : g == 1 ? ka->in[5] : ka->in[6]; const float* knew = ka->out + (g == 0 ? O_KVS0 : g == 1 ? O_KVS1 : O_KVS2);
            if (g == 0) { const int id = h * 128 + uidx, n = id >> 1, half = id & 1, lidx = F.wave & 3;
                attn_sample_unit<2>(QB, cache, knew, OG, LSE, n, 0, 4 * half + lidx, lidx, F.wave >> 2, xl, F.lane); }
            else { const int id = h * 256 + uidx, n = id >> 2, lp = id & 3, lidx = F.wave & 1, l = g == 2 ? 2 * lp + lidx : lp + 4 * lidx;
                attn_sample_unit<4>(QB, cache, knew, OG, LSE, n, g, l, lidx, F.wave >> 1, xl, F.lane); }
        } else { const int V = h * 384 + uidx, gp = V >> 8, rem = V & 255, b = rem >> 7, rem2 = rem & 127, hh = rem2 & 3, rem3 = rem2 >> 2, d = 1 << (2 * gp), r = rem3 % d, qb = rem3 / d;
            attn_prompt_unit(QB, KB, VB, OG, LSE, b, gp, r, hh, qb, F.lds, F.tid);
        }
        if (F.tid == 0) tk[0] = nxt_;
    }
}

__device__ __forceinline__ void phase_attn_merge(Frame& F) {
    KArgs ka = kargs(); unsigned char* ws = ka->ws; const bf16_t* OG = (const bf16_t*)(ws + WS_OG); const float* LSE = (const float*)(ws + WS_LSE); bf16_t* YA = (bf16_t*)(ws + WS_YGA) + DSSM;
    unsigned* ctr = (unsigned*)(ws + WS_CTL) + CW_TICK + 64 * 2;
    volatile LAS unsigned* tk = (volatile LAS unsigned*)(F.lds + MISC_OFF + 64);
    for (;;) {
        __syncthreads();
        if (F.tid == 0) tk[0] = __hip_atomic_fetch_add(ctr, 1u, __ATOMIC_RELAXED, __HIP_MEMORY_SCOPE_AGENT);
        __syncthreads();
        const int j = (int)tk[0]; if (j >= M / 64) break;
#pragma unroll 2
        for (int rr = 0; rr < 8; ++rr) { const int row = j * 64 + F.wave * 8 + rr;
            const int h = F.lane >> 4;
            const float l0 = LSE[((size_t)0 * M + row) * 4 + h], l1 = LSE[((size_t)1 * M + row) * 4 + h], l2 = LSE[((size_t)2 * M + row) * 4 + h];
            const float mx = fmaxf(l0, fmaxf(l1, l2)); float w0 = __builtin_amdgcn_exp2f(l0 - mx), w1 = __builtin_amdgcn_exp2f(l1 - mx), w2 = __builtin_amdgcn_exp2f(l2 - mx);
            const float inv = 1.f / (w0 + w1 + w2); w0 *= inv; w1 *= inv; w2 *= inv;
            const u32x2 a = *(const u32x2*)(OG + ((size_t)0 * M + row) * 256 + F.lane * 4), b = *(const u32x2*)(OG + ((size_t)1 * M + row) * 256 + F.lane * 4), c = *(const u32x2*)(OG + ((size_t)2 * M + row) * 256 + F.lane * 4);
            u32x2 w; w.x = cvtpk(w0 * bflo(a.x) + w1 * bflo(b.x) + w2 * bflo(c.x), w0 * bfhi(a.x) + w1 * bfhi(b.x) + w2 * bfhi(c.x));
            w.y = cvtpk(w0 * bflo(a.y) + w1 * bflo(b.y) + w2 * bflo(c.y), w0 * bfhi(a.y) + w1 * bfhi(b.y) + w2 * bfhi(c.y));
            *(u32x2*)(YA + (size_t)row * KMRG + F.lane * 4) = w; }
    }
}

__device__ __forceinline__ void ssm_scan_item(Frame& F, int b, int g) {
    KArgs ka = kargs(); unsigned char* ws = ka->ws; float* outp = ka->out; const float* SC = (const float*)(ws + WS_SC); const float* POW = (const float*)(ws + WS_POW); bf16_t* UGX = (bf16_t*)(ws + WS_UGX);
    const float* src = SC + ((size_t)g * NCR + b * NCH) * 128;
    LAS f32x4* L4 = (LAS f32x4*)F.lds;
    __syncthreads();
    { f32x4 t_[16];
#pragma unroll
      for (int i = 0; i < 16; ++i) t_[i] = ((const f32x4*)src)[F.tid + i * NWAVES * 64];
#pragma unroll
      for (int i = 0; i < 16; ++i) L4[F.tid + i * NWAVES * 64] = t_[i]; }
    __syncthreads();
    if (F.wave == 0) {
        const int p = F.lane; const float ar = POW[((size_t)(g * NP + p) * 33 + 32) * 2], ai = POW[((size_t)(g * NP + p) * 33 + 32) * 2 + 1];
        float hr = 0.f, hi = 0.f; const LAS f32x2* L2 = (const LAS f32x2*)F.lds;
#pragma unroll 8
        for (int c = 0; c < NCH; ++c) {
            *(unsigned*)(UGX + ((size_t)g * NCR + b * NCH + c) * UGP + 2 * p) = cvtpk(hr, hi);
            const f32x2 s = L2[c * 64 + p];
            const float nr = ar * hr - ai * hi + s.x, ni = ar * hi + ai * hr + s.y; hr = nr; hi = ni;
        }
        float* o = outp + O_SSMP + ((size_t)(b * NG + g) * NP + p) * 2; o[0] = hr; o[1] = hi;
    }
    VM_WAIT(); __syncthreads();
    __builtin_amdgcn_fence(__ATOMIC_ACQUIRE, "agent"); VM_WAIT();
    __syncthreads();
}

__device__ __forceinline__ void phase_final_norm(Frame& F) {
    KArgs ka = kargs(); const float* ssq4 = (const float*)(ka->ws + WS_SSQ) + 4 * (size_t)M; const float* gf = ka->in[33]; float* outp = ka->out;
    f32x4 gv[4];
#pragma unroll
    for (int j = 0; j < 4; ++j) gv[j] = ((const f32x4*)gf)[F.lane + 64 * j];
    for (int m = F.gw; m < M; m += F.NGW) {
        const float rs = rs_of(ssq4[m]); f32x4* xr = (f32x4*)(outp + (size_t)m * DM);
#pragma unroll
        for (int j = 0; j < 4; ++j) { f32x4 v = xr[F.lane + 64 * j]; xr[F.lane + 64 * j] = v * rs * gv[j]; }
    }
}

constexpr int N_PHASES = 12;
__global__ void __launch_bounds__(NWAVES * 64, 2) mk_fwd(Args args) {
    extern __shared__ __attribute__((aligned(16))) unsigned char lds_raw[];
    Frame F;
    F.lds = (LAS unsigned char*)lds_raw; F.tid = threadIdx.x; F.lane = F.tid & 63; F.wave = __builtin_amdgcn_readfirstlane(F.tid >> 6);
    F.G = gridDim.x; F.gw = blockIdx.x * NWAVES + F.wave; F.NGW = F.G * NWAVES;
    KArgs ka0 = kargs();
    unsigned char* ws = ka0->ws;
    volatile LAS unsigned* MISC = (volatile LAS unsigned*)(F.lds + MISC_OFF);
    for (int u = F.tid; u < (LDS_BYTES - LDSCTL_OFF) / 4; u += NWAVES * 64) ((LAS unsigned*)(F.lds + LDSCTL_OFF))[u] = 0u;
    __syncthreads();
    XcdBarrier bar; bar.bar = (unsigned*)(ws + WS_CTL) + CW_BAR; bar.x = 0; bar.st = nullptr;
    if (MK_N_LAUNCHES == 1) bar = xcd_barrier_post((unsigned*)(ws + WS_CTL) + CW_BAR, MISC + 8);
    const int lo = ka0->ph_lo, hi = ka0->ph_hi;
#ifdef PROBE_T
    if (F.tid == 0) { const unsigned long long t_ = __builtin_amdgcn_s_memrealtime(); MISC[28] = (unsigned)t_; MISC[29] = (unsigned)(t_ >> 32); }
#endif
#define IN(k) (lo <= (k) && (k) < hi)
#ifdef PROBE_T
#define SEAM(k) do { if (IN(k) && IN((k) + 1)) xcd_barrier(bar); if (F.tid == 0) { const unsigned long long t_ = __builtin_amdgcn_s_memrealtime(); MISC[32 + 2 * (k)] = (unsigned)t_; MISC[33 + 2 * (k)] = (unsigned)(t_ >> 32); } } while (0)
#else
#define SEAM(k) do { if (IN(k) && IN((k) + 1)) xcd_barrier(bar); } while (0)
#endif
    LAS unsigned char* ring = F.lds;
    const int cid = (int)blockIdx.x;
#define WSB(off) ((const bf16_t*)(ka->ws + (off)))
#define RUN(CFG, Aoff, Boff, C0, EA) do { Epi<CFG::KIND> E_{EA}; pg8::gemm_phase<CFG>(ring, Aoff, Boff, F.G, cid, C0, E_); } while (0)
#define MINI(CFG, Aoff, Boff, EA) do { for (int mu_ = cid; mu_ < 256; mu_ += F.G) mini_gemm<CFG::KIND, CFG::LDA, CFG::LDB, CFG::KK>(F, Aoff, Boff, mu_, EA); } while (0)
#define EA0() KArgs ka = kargs(); EpiArgs ea{}; ea.ws = ka->ws; ea.out = ka->out; ea.dskip = ka->in[21]

    for (int rep_ = 0; rep_ < 1 + ((PROBE_DUP >> 0) & 1); ++rep_) { if (IN(0)) { phase_prologue(F); } SEAM(0); }
    if (IN(1)) {
        phase_build_ssm(F, 1);
        EA0();
        { EpiArgs e = ea; e.ssq_i = 0; RUN(CfgGU, WSB(WS_XB), WSB(WS_W1GU), 0, e); }
    } SEAM(1);
    if (IN(2)) { phase_build_ssm(F, 2); EA0(); EpiArgs e = ea; e.base0 = ka->in[0]; e.base1 = ka->in[1]; e.ssq_o = 1; e.alpha = 0.5f; RUN(CfgDown, WSB(WS_HID), WSB(WS_W1D), 0, e); MINI(CfgDown, WSB(WS_HID), WSB(WS_W1D), e); } SEAM(2);
    if (IN(3)) { EA0(); EpiArgs e = ea; e.ssq_i = 1; RUN(CfgWin, WSB(WS_XB), WSB(WS_WIN), 0, e);
        constexpr int WIN_LEFT = (M / 256 * 19) % 256;
        if (F.G == 256 && cid >= WIN_LEFT) { Epi<EK_PP> E_{ea}; pg8::gemm_phase<CfgPP>(ring, WSB(WS_PB), WSB(WS_WPP), 256 - WIN_LEFT, cid - WIN_LEFT, 0, E_); }
        else if (F.G != 256) { RUN(CfgPP, WSB(WS_PB), WSB(WS_WPP), 0, ea); } } SEAM(3);
    if (IN(4)) {
        { EA0(); RUN(CfgS1, WSB(WS_UGX) + 128, WSB(WS_WM), 0, ea); RUN(CfgSS, WSB(WS_USX), WSB(WS_BS), 64, ea); }
        phase_attention(F, 0);
    } SEAM(4);
    if (IN(5)) {
        if (cid < 2 * NB * NG) { ssm_scan_item(F, (cid >> 1) & 1, cid >> 2); EA0(); RUN(CfgS2, WSB(WS_UGX), WSB(WS_B2), 0, ea); }
        phase_attention(F, 1);
    } SEAM(5);
    if (IN(6)) { { EA0(); RUN(CfgGLU, WSB(WS_YS), WSB(WS_WGLU), 0, ea); } phase_attn_merge(F); } SEAM(6);
    if (IN(7)) { EA0(); RUN(CfgMrg, WSB(WS_YGA), WSB(WS_WBS), 0, ea); MINI(CfgMrg, WSB(WS_YGA), WSB(WS_WBS), ea); } SEAM(7);
    if (IN(8)) { EA0(); EpiArgs e = ea; e.base0 = ka->out; e.base1 = ka->out + (size_t)MP * DM; e.ssq_o = 2; e.alpha = 1.0f; RUN(CfgOut, WSB(WS_MRG), WSB(WS_WOUT), 0, e); MINI(CfgOut, WSB(WS_MRG), WSB(WS_WOUT), e); } SEAM(8);
    if (IN(9)) { EA0(); EpiArgs e = ea; e.ssq_i = 2; RUN(CfgGU, WSB(WS_XB), WSB(WS_W2GU), 0, e); } SEAM(9);
    if (IN(10)) { EA0(); EpiArgs e = ea; e.base0 = ka->out; e.base1 = ka->out + (size_t)MP * DM; e.ssq_o = 3; e.alpha = 0.5f; RUN(CfgDown, WSB(WS_HID), WSB(WS_W2D), 0, e); MINI(CfgDown, WSB(WS_HID), WSB(WS_W2D), e); } SEAM(10);
    if (IN(11)) { EA0(); EpiArgs e = ea; e.base0 = ka->out; e.base1 = ka->out + (size_t)MP * DM; e.ssq_i = 3; e.ssq_o = 4; RUN(CfgPle, WSB(WS_XB), WSB(WS_WPG), 0, e); MINI(CfgPle, WSB(WS_XB), WSB(WS_WPG), e); } SEAM(11);
    if (IN(12)) { phase_final_norm(F); }
#ifdef PROBE_T
    __syncthreads();
    if (blockIdx.x == 0) { KArgs ka = kargs(); const unsigned long long t1 = ((unsigned long long)MISC[33 + 2 * PROBE_T] << 32) | MISC[32 + 2 * PROBE_T];
        unsigned long long t0 = PROBE_T > 0 ? (((unsigned long long)MISC[31 + 2 * PROBE_T] << 32) | MISC[30 + 2 * PROBE_T]) : (((unsigned long long)MISC[29] << 32) | MISC[28]);
        const float us = (float)(long long)(t1 - t0) * 0.01f; float* sp = ka->out + O_SSMP;
        for (int i = F.tid; i < 8192; i += 512) sp[i] *= (1.f + us * 0.001f); }
#endif
#undef IN
#undef SEAM
}

extern "C" void kernel_launch(void* const* d_in, const int* in_sizes, int n_in, void* d_out, int out_size, void* d_ws, size_t ws_size, hipStream_t stream) {
    static int grid = 0;
    if (grid == 0) {
        if (n_in != 34 || out_size != (int)O_END || ws_size < WS_END) { fprintf(stderr, "kernel_launch: unexpected shapes (n_in %d, out %d, ws %zu)\n", n_in, out_size, ws_size); grid = -1; return; }
        int dev = 0, cus = 0, per_cu = 0;
        if (hipGetDevice(&dev) != hipSuccess || hipDeviceGetAttribute(&cus, hipDeviceAttributeMultiprocessorCount, dev) != hipSuccess) { grid = -1; return; }
        if (hipFuncSetAttribute((const void*)mk_fwd, hipFuncAttributeMaxDynamicSharedMemorySize, LDS_BYTES) != hipSuccess) { fprintf(stderr, "kernel_launch: hipFuncSetAttribute failed\n"); grid = -1; return; }
        if (hipOccupancyMaxActiveBlocksPerMultiprocessor(&per_cu, (const void*)mk_fwd, NWAVES * 64, LDS_BYTES) != hipSuccess || per_cu < 1) { fprintf(stderr, "kernel_launch: occupancy query says %d\n", per_cu); }
        (void)hipGetLastError();
        grid = cus;
    }
    if (grid < 0) return;
    (void)hipMemsetAsync((char*)d_ws + WS_CTL, 0, CTL_ZERO_BYTES, stream);
    Args a{};
    for (int i = 0; i < 34; ++i) a.in[i] = (const float*)d_in[i];
    a.out = (float*)d_out; a.ws = (unsigned char*)d_ws;
    if (MK_N_LAUNCHES == 1) { a.ph_lo = 0; a.ph_hi = N_PHASES + 1; hipLaunchKernelGGL(mk_fwd, dim3(grid), dim3(NWAVES * 64), LDS_BYTES, stream, a); }
    else for (int p = 0; p <= N_PHASES; ++p) { a.ph_lo = p; a.ph_hi = p + 1; hipLaunchKernelGGL(mk_fwd, dim3(grid), dim3(NWAVES * 64), LDS_BYTES, stream, a); }
}
```

```cpp
#include <hip/hip_runtime.h>
#include <cstdio>
#include <cstdint>

#ifndef MK_N_LAUNCHES
#define MK_N_LAUNCHES 1
#endif

#ifndef PROBE_DUP
#define PROBE_DUP 0
#endif
#define LAS __attribute__((address_space(3)))
#define GAS __attribute__((address_space(1)))
typedef unsigned short bf16_t;
typedef short bf16x8 __attribute__((ext_vector_type(8)));
typedef short s16x4 __attribute__((ext_vector_type(4)));
typedef float f32x4 __attribute__((ext_vector_type(4)));
typedef float f32x2 __attribute__((ext_vector_type(2)));
typedef float f32x16 __attribute__((ext_vector_type(16)));
typedef unsigned u32x4 __attribute__((ext_vector_type(4)));
typedef unsigned u32x2 __attribute__((ext_vector_type(2)));
typedef __bf16 bf16x2_t __attribute__((ext_vector_type(2)));

constexpr int DM = 1024, SEQ = 8192, NB = 2, MP = NB * SEQ, NSB = 128, NSL = 8, MS = NSB * NSL, M = MP + MS;
constexpr int DFF = 2816, DPLE = 256, DSSM = 512, NG = 32, NP = 64, DIN = 4864;
constexpr int KMRG = 768;
constexpr int TCH = 32, NCH = SEQ / TCH, NCR = NB * NCH;
constexpr int UGP = 128 + TCH * 16;
constexpr float EPS = 1e-6f, LOG2E = 1.4426950408889634f, QSCALE = 0.125f * 1.4426950408889634f;

constexpr size_t O_Y = 0, O_KVP0 = (size_t)M * DM, O_KVP1 = O_KVP0 + 131072, O_KVP2 = O_KVP1 + 524288, O_SSMP = O_KVP2 + 2097152,
                 O_KVS0 = O_SSMP + 8192, O_KVS1 = O_KVS0 + 524288, O_KVS2 = O_KVS1 + 524288, O_SSMS = O_KVS2 + 524288, O_END = O_SSMS + 524288;

constexpr size_t MiB = 1u << 20;
constexpr size_t WS_CTL = 0, CTL_ZERO_BYTES = 1 * MiB;
constexpr size_t WS_SSQ = 512 * 1024;
constexpr size_t WS_W1GU = 2 * MiB, WS_W1D = 14 * MiB, WS_WIN = 20 * MiB, WS_WGLU = 30 * MiB, WS_WBS = 31 * MiB, WS_WBA = 32 * MiB, WS_WOUT = 33 * MiB,
                 WS_W2GU = 36 * MiB, WS_W2D = 48 * MiB, WS_WPG = 54 * MiB, WS_WPP = 57 * MiB, WS_WM = 58 * MiB, WS_B2 = 67 * MiB, WS_BS = 88 * MiB,
                 WS_KTAB = 93 * MiB, WS_POW = 95 * MiB, WS_BBAR = 96 * MiB;
constexpr size_t WS_XB = 100 * MiB, WS_HID = 136 * MiB, WS_QB = 232 * MiB, WS_KB = 258 * MiB, WS_VB = 284 * MiB, WS_SA = 310 * MiB, WS_SB = 346 * MiB,
                 WS_UGX = 382 * MiB, WS_USX = 403 * MiB, WS_SC = 406 * MiB, WS_YS = 415 * MiB, WS_YGOLD = 433 * MiB, WS_OG = 451 * MiB, WS_LSE = 478 * MiB,
                 WS_YATTOLD = 480 * MiB, WS_YGA = 490 * MiB  , WS_MRG = 526 * MiB, WS_PP = 562 * MiB, WS_PB = 598 * MiB, WS_END = 608 * MiB;
static_assert(WS_W1GU + (size_t)5632 * 1024 * 2 <= WS_W1D && WS_W1D + (size_t)1024 * 2816 * 2 <= WS_WIN && WS_WIN + (size_t)DIN * 1024 * 2 <= WS_WGLU, "ws map 1");
static_assert(WS_WM + (size_t)NG * 256 * 512 * 2 <= WS_B2 && WS_B2 + (size_t)NG * 512 * UGP * 2 <= WS_BS && WS_BS + (size_t)NG * 256 * 256 * 2 <= WS_KTAB, "ws map 2");
static_assert(WS_XB + (size_t)M * DM * 2 <= WS_HID && WS_HID + (size_t)M * DFF * 2 <= WS_QB && WS_QB + (size_t)M * 768 * 2 <= WS_KB && WS_SA + (size_t)M * DM * 2 <= WS_SB, "ws map 3");
static_assert(WS_UGX + (size_t)NG * NCR * UGP * 2 <= WS_USX && WS_USX + (size_t)(NG + 1) * 128 * 256 * 2 <= WS_SC && WS_SC + (size_t)NG * NCR * 128 * 4 <= WS_YS, "ws map 4");
static_assert(WS_YS + (size_t)M * 512 * 2 <= WS_YGOLD && WS_OG + (size_t)3 * M * 256 * 2 <= WS_LSE && WS_LSE + (size_t)3 * M * 4 * 4 <= WS_YATTOLD && WS_YGA + (size_t)M * 768 * 2 <= WS_MRG, "ws map 5");
static_assert(WS_PB + (size_t)M * 256 * 2 <= WS_END && 5 * (size_t)M * 4 + WS_SSQ <= CTL_ZERO_BYTES, "ws map 6");
constexpr int CW_BAR = 4096;

constexpr int RING_BYTES = 131072, LDSCTL_OFF = RING_BYTES, MISC_OFF = LDSCTL_OFF + 320, LDS_BYTES = 147456;
constexpr int NWAVES = 8;

__device__ __forceinline__ unsigned cvtpk(float lo, float hi) { f32x2 v = {lo, hi}; bf16x2_t b = __builtin_convertvector(v, bf16x2_t); return __builtin_bit_cast(unsigned, b); }
__device__ __forceinline__ float bflo(unsigned w) { return __uint_as_float(w << 16); }
__device__ __forceinline__ float bfhi(unsigned w) { return __uint_as_float(w & 0xffff0000u); }
__device__ __forceinline__ u32x4 pack8(f32x4 a, f32x4 b) { u32x4 w; w.x = cvtpk(a[0], a[1]); w.y = cvtpk(a[2], a[3]); w.z = cvtpk(b[0], b[1]); w.w = cvtpk(b[2], b[3]); return w; }
__device__ __forceinline__ void unpack8(u32x4 w, f32x4& a, f32x4& b) { a = (f32x4){bflo(w.x), bfhi(w.x), bflo(w.y), bfhi(w.y)}; b = (f32x4){bflo(w.z), bfhi(w.z), bflo(w.w), bfhi(w.w)}; }
__device__ __forceinline__ float sigmoidf_(float x) { return __builtin_amdgcn_rcpf(1.f + __builtin_amdgcn_exp2f(-x * LOG2E)); }
__device__ __forceinline__ f32x4 sigmoid4(f32x4 v) { return (f32x4){sigmoidf_(v[0]), sigmoidf_(v[1]), sigmoidf_(v[2]), sigmoidf_(v[3])}; }
__device__ __forceinline__ float gelu_tanh(float y) { const float z2 = 1.5957691216057308f * (y + 0.044715f * y * y * y); return y * sigmoidf_(z2); }
__device__ __forceinline__ f32x4 gelu4(f32x4 v) { return (f32x4){gelu_tanh(v[0]), gelu_tanh(v[1]), gelu_tanh(v[2]), gelu_tanh(v[3])}; }
__device__ __forceinline__ float rs_of(float ssq) { return __builtin_amdgcn_rsqf(ssq * (1.f / DM) + EPS); }
#define LDS_WAIT() asm volatile("s_waitcnt lgkmcnt(0)" ::: "memory")
#define VM_WAIT() asm volatile("s_waitcnt vmcnt(0)" ::: "memory")

namespace pg8 {
constexpr int BM = 256, BK = 64, HALF = 128, HTB = HALF * BK * 2, NXCD = 8, WGM = 8;
__device__ __forceinline__ int lds_byte(int r, int c) { const int st = (r >> 4) * 2 + (c >> 5), rr = r & 15, cc = c & 31, ob = rr * 64 + cc * 2; return st * 1024 + (ob ^ (((ob >> 9) & 1) << 5)); }
__device__ __forceinline__ void stage_rc(int b, int& R, int& C) { const int st = b / 1024, sb = b % 1024, swz = sb ^ (((sb >> 9) & 1) << 5); R = (st >> 1) * 16 + swz / 64; C = (st & 1) * 32 + (swz % 64) / 2; }
__device__ __forceinline__ int perm32(int rho) { const int n = rho >> 4, i = rho & 15; return 8 * (i >> 2) + 4 * n + (i & 3); }

struct Unit { int pm, pn, g, part; };
template <int nM, int nN, int nG, int UPC = 0, bool DUAL = false> struct Order {
    static constexpr int nwg = nM * nN * nG;
    int G, c;
    __device__ __forceinline__ void init(int G_, int c_, int c0) { G = G_; c = (c_ - c0 % G_ + G_) % G_; }
    __device__ __forceinline__ bool next(int i, Unit& u) const {
        u.part = 0; if constexpr (DUAL) { u.part = i & 1; i >>= 1; }
        long L = (long)i * G + c; if constexpr (UPC > 0) { if (i >= UPC) return false; L = (long)c * UPC + i; }
        if (L >= nwg) return false;
        int wgid = (int)L;
        if constexpr (nG == 1) {
            { constexpr int q = nwg / NXCD, r = nwg % NXCD; const int xcd = wgid % NXCD, off = wgid / NXCD; wgid = (xcd < r ? xcd * (q + 1) : r * (q + 1) + (xcd - r) * q) + off; }
            constexpr int nig = WGM * nN; const int gid = wgid / nig, fm = gid * WGM, gsz = (nM - fm) < WGM ? (nM - fm) : WGM;
            u.pm = fm + ((wgid % nig) % gsz); u.pn = (wgid % nig) / gsz; u.g = 0;
        } else { u.g = wgid / (nM * nN); const int r = wgid % (nM * nN); u.pm = r / nN; u.pn = r % nN; }
        return true;
    }
};

template <class C, class Epi>
__device__ __forceinline__ void gemm_phase(LAS unsigned char* lds, const bf16_t* gA, const bf16_t* gBt, int Gsz, int cu, int c0, const Epi& E) {
    int tid = threadIdx.x; asm volatile("" : "+v"(tid));
    const int wid = __builtin_amdgcn_readfirstlane(tid >> 6), lane = tid & 63, wr = wid >> 2, wc = wid & 3, fr = lane & 15, fq = lane >> 4;
    constexpr int nt = C::KK / BK;
    struct { const bf16_t* A; const bf16_t* Bt; } g{gA, gBt};
    Order<C::NM, C::NN, C::NGRP, C::UPC, (C::MIDT > 0)> S; S.init(Gsz, cu, c0);
    unsigned voffA[2], voffB[2];
#pragma unroll
    for (int i = 0; i < 2; ++i) { int R, Cc; stage_rc(tid * 16 + i * 8192, R, Cc); const int Rb = (R & ~31) + perm32(R & 31);
        voffA[i] = (unsigned)(R * C::LDA + Cc) * 2u; voffB[i] = (unsigned)(Rb * C::LDB + Cc) * 2u; }
    constexpr size_t kstep = (size_t)(BK * 2);
    constexpr size_t hstepA = (size_t)HALF * C::LDA * 2, hstepB = (size_t)HALF * C::LDB * 2;
    const unsigned ldsw = (unsigned)wid * 1024u;
    const int aoff = lds_byte(wr * 64 + fr, fq * 8), boff = lds_byte(wc * 32 + fr, fq * 8);
#define PG8_SA(b, h) (((b) * 2 + (h)) * HTB)
#define PG8_SB(b, h) ((4 + (b) * 2 + (h)) * HTB)
#define PG8_STAGE(bufoff, gbase, voff) do { _Pragma("unroll") for (int _i = 0; _i < 2; ++_i) \
        __builtin_amdgcn_global_load_lds((const unsigned*)((const char*)(gbase) + (voff)[_i]), (LAS unsigned*)(lds + (bufoff) + ldsw + _i * 8192), 16, 0, 0); } while (0)
#define PG8_LDA(dst, b, h) do { _Pragma("unroll") for (int m = 0; m < 4; ++m) _Pragma("unroll") for (int k = 0; k < 2; ++k) dst[m][k] = *(const LAS bf16x8*)(lds + PG8_SA(b, h) + aoff + m * 2048 + k * 1024); } while (0)
#define PG8_LDB(dst, b, h) do { _Pragma("unroll") for (int n = 0; n < 2; ++n) _Pragma("unroll") for (int k = 0; k < 2; ++k) dst[n][k] = *(const LAS bf16x8*)(lds + PG8_SB(b, h) + boff + n * 2048 + k * 1024); } while (0)
#define PG8_MMA(ai, bj, At, Bt) do { __builtin_amdgcn_s_setprio(1); _Pragma("unroll") for (int m = 0; m < 4; ++m) _Pragma("unroll") for (int n = 0; n < 2; ++n) _Pragma("unroll") for (int k = 0; k < 2; ++k) \
        acc[ai][bj][m][n] = __builtin_amdgcn_mfma_f32_16x16x32_bf16(Bt[n][k], At[m][k], acc[ai][bj][m][n], 0, 0, 0); __builtin_amdgcn_s_setprio(0); } while (0)
#define PG8_WAIT_V(n) asm volatile("s_waitcnt vmcnt(" #n ")" ::: "memory")
#define PG8_WAIT_L(n) asm volatile("s_waitcnt lgkmcnt(" #n ")" ::: "memory")
#define PG8_BAR __builtin_amdgcn_s_barrier()
#define PG8_SCHED __builtin_amdgcn_sched_barrier(0)
    Unit cur, nxt; int ui = 0;
    if (!S.next(0, cur)) return;
    f32x4 acc[2][2][4][2];
#pragma unroll
    for (int a = 0; a < 2; ++a)
#pragma unroll
        for (int b = 0; b < 2; ++b)
#pragma unroll
            for (int m = 0; m < 4; ++m)
#pragma unroll
                for (int n = 0; n < 2; ++n) acc[a][b][m][n] = (f32x4){0.f, 0.f, 0.f, 0.f};
    bf16x8 At[4][2], B0[2][2], B1[2][2];
    const char* cA = (const char*)(g.A + (size_t)cur.g * C::GSA) + (size_t)cur.pm * 2 * hstepA; const char* cB = (const char*)(g.Bt + (size_t)cur.g * C::GSB) + (size_t)cur.pn * 2 * hstepB;
    PG8_STAGE(PG8_SB(0, 0), cB, voffB); PG8_STAGE(PG8_SB(0, 1), cB + hstepB, voffB); PG8_STAGE(PG8_SA(0, 0), cA, voffA); PG8_STAGE(PG8_SA(0, 1), cA + hstepA, voffA);
    if (wr == 1) PG8_BAR;
    PG8_WAIT_V(2); PG8_BAR;
    PG8_STAGE(PG8_SB(1, 0), cB + kstep, voffB); PG8_STAGE(PG8_SA(1, 0), cA + kstep, voffA); PG8_STAGE(PG8_SB(1, 1), cB + hstepB + kstep, voffB);
    PG8_WAIT_V(6); PG8_BAR;
    for (;;) {
        const bool has_next = S.next(ui + 1, nxt);
        const size_t poff = (C::MIDT > 0 && has_next && nxt.part) ? (size_t)C::MIDT * kstep : 0;
        const char* nA = has_next ? (const char*)(g.A + (size_t)nxt.g * C::GSA) + (size_t)nxt.pm * 2 * hstepA + poff : cA;
        const char* nB = has_next ? (const char*)(g.Bt + (size_t)nxt.g * C::GSB) + (size_t)nxt.pn * 2 * hstepB + poff : cB;
        const int ntc = C::MIDT > 0 ? (cur.part ? nt - C::MIDT : C::MIDT) : nt;
#pragma unroll 1
        for (int t = 0; t < ntc; t += 2) {
            const bool last = (t == ntc - 2);
            const char* a1 = cA + (size_t)(t + 1) * kstep;
            const char* a2 = last ? nA : cA + (size_t)(t + 2) * kstep; const char* b2 = last ? nB : cB + (size_t)(t + 2) * kstep;
            const char* a3 = a2 + kstep; const char* b3 = b2 + kstep;
            PG8_LDB(B0, 0, 0); PG8_LDB(B1, 0, 1); PG8_SCHED; PG8_LDA(At, 0, 0); PG8_STAGE(PG8_SA(1, 1), a1 + hstepA, voffA);
            PG8_WAIT_V(8); PG8_WAIT_L(0); PG8_BAR; PG8_MMA(0, 0, At, B0); PG8_MMA(0, 1, At, B1); PG8_BAR; PG8_SCHED;
            PG8_LDA(At, 0, 1); PG8_STAGE(PG8_SB(0, 0), b2, voffB); PG8_STAGE(PG8_SB(0, 1), b2 + hstepB, voffB); PG8_STAGE(PG8_SA(0, 0), a2, voffA);
            PG8_WAIT_V(8); PG8_WAIT_L(0); PG8_BAR; PG8_MMA(1, 0, At, B0); PG8_MMA(1, 1, At, B1); PG8_BAR; PG8_SCHED;
            PG8_LDB(B0, 1, 0); PG8_LDB(B1, 1, 1); PG8_SCHED; PG8_LDA(At, 1, 0); PG8_STAGE(PG8_SA(0, 1), a2 + hstepA, voffA);
            PG8_WAIT_V(8); PG8_WAIT_L(0); PG8_BAR; PG8_MMA(0, 0, At, B0); PG8_MMA(0, 1, At, B1); PG8_BAR; PG8_SCHED;
            PG8_LDA(At, 1, 1); PG8_STAGE(PG8_SB(1, 0), b3, voffB); PG8_STAGE(PG8_SB(1, 1), b3 + hstepB, voffB); PG8_STAGE(PG8_SA(1, 0), a3, voffA);
            PG8_WAIT_V(8); PG8_WAIT_L(0); PG8_BAR; PG8_MMA(1, 0, At, B0); PG8_MMA(1, 1, At, B1); PG8_BAR; PG8_SCHED;
        }
        if (wr == 0) PG8_BAR;
        const bool midp = C::MIDT > 0 && cur.part == 0;
        if (midp) E.mid(acc, cur, wr, wc, fr, fq); else E(acc, cur, wr, wc, fr, fq);
        if (!has_next) break;
        if (!midp) {
#pragma unroll
        for (int a = 0; a < 2; ++a)
#pragma unroll
            for (int b = 0; b < 2; ++b)
#pragma unroll
                for (int m = 0; m < 4; ++m)
#pragma unroll
                    for (int n = 0; n < 2; ++n) acc[a][b][m][n] = (f32x4){0.f, 0.f, 0.f, 0.f};
        }
        cur = nxt; cA = nA; cB = nB; ++ui;
        if (wr == 1) PG8_BAR;
    }
    PG8_WAIT_V(0);
    PG8_BAR;
#undef PG8_SA
#undef PG8_SB
#undef PG8_STAGE
#undef PG8_LDA
#undef PG8_LDB
#undef PG8_MMA
#undef PG8_WAIT_V
#undef PG8_WAIT_L
#undef PG8_BAR
#undef PG8_SCHED
}
}


struct Args { const float* in[34]; float* out; unsigned char* ws; int ph_lo, ph_hi; };

struct Frame {
    LAS unsigned char* lds; int tid, lane, wave, G, gw, NGW;
};
typedef const float* cfp_t;
typedef const __attribute__((address_space(4))) Args* KArgs;
__device__ __forceinline__ KArgs kargs() { KArgs p = (KArgs)__builtin_amdgcn_kernarg_segment_ptr(); asm volatile("" : "+s"(p)); return p; }
__device__ __forceinline__ float wave_sum(float v) {
#pragma unroll
    for (int o = 1; o < 64; o <<= 1) v += __shfl_xor(v, o);
    return v;
}

enum { EK_SWIGLU = 1, EK_RESID, EK_PLE, EK_WIN, EK_S1, EK_S2, EK_SS, EK_GLU, EK_MRG, EK_PP };
struct EpiArgs {
    unsigned char* ws; float* out;
    const float* base0; const float* base1;
    const float* dskip;
    int ssq_i, ssq_o;
    float alpha;
};
#define WSP(T, off) ((T*)(a.ws + (off)))
template <int KIND> __device__ __forceinline__ float resid8(const EpiArgs& a, int row, int col, f32x4 x0, f32x4 x1) {
    f32x4 b0, b1;
    if (a.base0) { const float* bp = row < MP ? a.base0 + (size_t)row * DM : a.base1 + (size_t)(row - MP) * DM; b0 = *(const f32x4*)(bp + col); b1 = *(const f32x4*)(bp + col + 4); }
    else unpack8(*(const u32x4*)(WSP(const bf16_t, WS_XB) + (size_t)row * DM + col), b0, b1);
    f32x4 v0, v1;
    if constexpr (KIND == EK_PLE) { const float rs = rs_of(WSP(const float, WS_SSQ)[(size_t)a.ssq_i * M + row]); f32x4 p0, p1; unpack8(*(const u32x4*)(WSP(const bf16_t, WS_PP) + (size_t)row * DM + col), p0, p1);
        v0 = b0 + sigmoid4(x0 * rs) * p0; v1 = b1 + sigmoid4(x1 * rs) * p1; }
    else { v0 = b0 + a.alpha * x0; v1 = b1 + a.alpha * x1; }
    if constexpr (KIND == EK_PLE) { *(f32x4*)(a.out + (size_t)row * DM + col) = v0; *(f32x4*)(a.out + (size_t)row * DM + col + 4) = v1; }
    if constexpr (KIND == EK_RESID) *(u32x4*)(WSP(bf16_t, WS_XB) + (size_t)row * DM + col) = pack8(v0, v1);
    return (v0[0] * v0[0] + v0[1] * v0[1]) + (v0[2] * v0[2] + v0[3] * v0[3]) + (v1[0] * v1[0] + v1[1] * v1[1]) + (v1[2] * v1[2] + v1[3] * v1[3]);
}
template <int KIND> struct Epi {
    EpiArgs a;
    __device__ __forceinline__ void mid(f32x4 (&acc)[2][2][4][2], const pg8::Unit& u, int wr, int wc, int fr, int fq) const {
        const int c8t = wc * 32 + 8 * fq;
#pragma unroll
        for (int ai = 0; ai < 2; ++ai)
#pragma unroll
            for (int m = 0; m < 4; ++m) { const int row = u.pm * 256 + ai * 128 + wr * 64 + m * 16 + fr;
#pragma unroll
                for (int bj = 0; bj < 2; ++bj) { const int col = u.pn * 256 + bj * 128 + c8t;
                    f32x4 a0, a1, b0, b1; unpack8(*(const u32x4*)(WSP(const bf16_t, WS_SA) + (size_t)row * DM + col), a0, a1); unpack8(*(const u32x4*)(WSP(const bf16_t, WS_SB) + (size_t)row * DM + col), b0, b1);
#pragma unroll
                    for (int e = 0; e < 4; ++e) { acc[ai][bj][m][0][e] *= a0[e] * __builtin_amdgcn_rcpf(b0[e]); acc[ai][bj][m][1][e] *= a1[e] * __builtin_amdgcn_rcpf(b1[e]); } }
                asm volatile("" ::: "memory"); }
    }
    __device__ __forceinline__ void operator()(f32x4 (&acc)[2][2][4][2], const pg8::Unit& u, int wr, int wc, int fr, int fq) const {
        const int c8t = wc * 32 + 8 * fq;
#pragma unroll
        for (int ai = 0; ai < 2; ++ai)
#pragma unroll
            for (int m = 0; m < 4; ++m) {
                const int row = u.pm * 256 + ai * 128 + wr * 64 + m * 16 + fr;
                if constexpr (KIND == EK_SWIGLU) {
                    const float rs = rs_of(WSP(const float, WS_SSQ)[(size_t)a.ssq_i * M + row]);
                    const f32x4 g0 = acc[ai][0][m][0] * rs, g1 = acc[ai][0][m][1] * rs, u0 = acc[ai][1][m][0] * rs, u1 = acc[ai][1][m][1] * rs;
                    const f32x4 h0 = g0 * sigmoid4(g0) * u0, h1 = g1 * sigmoid4(g1) * u1;
                    *(u32x4*)(WSP(bf16_t, WS_HID) + (size_t)row * DFF + u.pn * 128 + c8t) = pack8(h0, h1);
                } else if constexpr (KIND == EK_RESID || KIND == EK_PLE) {
                    float sq = 0.f;
#pragma unroll
                    for (int bj = 0; bj < 2; ++bj) sq += resid8<KIND>(a, row, u.pn * 256 + bj * 128 + c8t, acc[ai][bj][m][0], acc[ai][bj][m][1]);
                    sq += __shfl_xor(sq, 16); sq += __shfl_xor(sq, 32);
                    if (fq == 0) atomicAdd(WSP(float, WS_SSQ) + (size_t)a.ssq_o * M + row, sq);
                } else if constexpr (KIND == EK_WIN) {
                    const float rs = rs_of(WSP(const float, WS_SSQ)[(size_t)a.ssq_i * M + row]);
                    const int pn = u.pn;
#pragma unroll
                    for (int bj = 0; bj < 2; ++bj) {
                        const int c8 = bj * 128 + c8t;
                        f32x4 v0 = acc[ai][bj][m][0] * rs, v1 = acc[ai][bj][m][1] * rs;
                        if (pn < 2) {
                            const int col = pn * 256 + c8, grp = col >> 4, ch0 = col & 15;
                            bf16_t* dst = row < MP ? WSP(bf16_t, WS_UGX) + ((size_t)grp * NCR + (row >> 5)) * UGP + 128 + (row & 31) * 16 + ch0
                                                   : WSP(bf16_t, WS_USX) + ((size_t)grp * 128 + ((row - MP) >> 3)) * 256 + 128 + ((row - MP) & 7) * 16 + ch0;
                            *(u32x4*)dst = pack8(v0, v1);
                        } else if (pn < 5) {
                            *(u32x4*)(WSP(bf16_t, WS_QB) + (size_t)row * 768 + (pn - 2) * 256 + c8) = pack8(v0 * QSCALE, v1 * QSCALE);
                        } else if (pn < 11) {
                            const int kvsel = pn >= 8 ? 1 : 0, gq = (pn - 5) % 3, keep = 128 << (2 * gq);
                            *(u32x4*)(WSP(bf16_t, (kvsel ? WS_VB : WS_KB)) + (size_t)row * 768 + gq * 256 + c8) = pack8(v0, v1);
                            float* fo = nullptr;
                            if (row >= MP) fo = a.out + (gq == 0 ? O_KVS0 : gq == 1 ? O_KVS1 : O_KVS2) + ((size_t)(row - MP) * 2 + kvsel) * 256 + c8;
                            else { const int b = row >> 13, t = row & (SEQ - 1); if (t >= SEQ - keep) fo = a.out + (gq == 0 ? O_KVP0 : gq == 1 ? O_KVP1 : O_KVP2) + (((size_t)b * keep + (t - (SEQ - keep))) * 2 + kvsel) * 256 + c8; }
                            if (fo) { *(f32x4*)fo = v0; *(f32x4*)(fo + 4) = v1; }
                        } else {
                            *(u32x4*)(WSP(bf16_t, (pn < 15 ? WS_SA : WS_SB)) + (size_t)row * DM + ((pn - 11) & 3) * 256 + c8) = pack8(sigmoid4(v0), sigmoid4(v1));
                        }
                    }
                } else if constexpr (KIND == EK_S1) {
                    if (u.pn == 0) { float* d = WSP(float, WS_SC) + ((size_t)u.g * NCR + row) * 128 + c8t; *(f32x4*)d = acc[ai][0][m][0]; *(f32x4*)(d + 4) = acc[ai][0][m][1]; }
                } else if constexpr (KIND == EK_S2) {
#pragma unroll
                    for (int bj = 0; bj < 2; ++bj) {
                        const int col = u.pn * 256 + bj * 128 + c8t, t = col >> 4, ch0 = col & 15;
                        f32x4 u0, u1; unpack8(*(const u32x4*)(WSP(const bf16_t, WS_UGX) + ((size_t)u.g * NCR + row) * UGP + 128 + t * 16 + ch0), u0, u1);
                        const f32x4 d0 = *(const f32x4*)(a.dskip + u.g * 16 + ch0), d1 = *(const f32x4*)(a.dskip + u.g * 16 + ch0 + 4);
                        const f32x4 y0 = gelu4(acc[ai][bj][m][0] + d0 * u0), y1 = gelu4(acc[ai][bj][m][1] + d1 * u1);
                        *(u32x4*)(WSP(bf16_t, WS_YS) + ((size_t)row * TCH + t) * DSSM + u.g * 16 + ch0) = pack8(y0, y1);
                    }
                } else if constexpr (KIND == EK_SS) {
                    if (ai == 0) {
                        const int n = row;
                        { const int col = c8t, l = col >> 4, ch0 = col & 15;
                          f32x4 u0, u1; unpack8(*(const u32x4*)(WSP(const bf16_t, WS_USX) + ((size_t)u.g * 128 + n) * 256 + 128 + l * 16 + ch0), u0, u1);
                          const f32x4 d0 = *(const f32x4*)(a.dskip + u.g * 16 + ch0), d1 = *(const f32x4*)(a.dskip + u.g * 16 + ch0 + 4);
                          const f32x4 y0 = gelu4(acc[0][0][m][0] + d0 * u0), y1 = gelu4(acc[0][0][m][1] + d1 * u1);
                          *(u32x4*)(WSP(bf16_t, WS_YS) + ((size_t)(MP + n * 8 + l)) * DSSM + u.g * 16 + ch0) = pack8(y0, y1); }
                        { float* d = a.out + O_SSMS + ((size_t)n * NG + u.g) * 128 + c8t; *(f32x4*)d = acc[0][1][m][0]; *(f32x4*)(d + 4) = acc[0][1][m][1]; }
                    }
                } else if constexpr (KIND == EK_GLU) {
#pragma unroll
                    for (int bj = 0; bj < 2; ++bj) { const int col = u.pn * 256 + bj * 128 + c8t;
                        f32x4 y0, y1; unpack8(*(const u32x4*)(WSP(const bf16_t, WS_YS) + (size_t)row * DSSM + col), y0, y1);
                        *(u32x4*)(WSP(bf16_t, WS_YGA) + (size_t)row * KMRG + col) = pack8(y0 * sigmoid4(acc[ai][bj][m][0]), y1 * sigmoid4(acc[ai][bj][m][1])); }
                } else if constexpr (KIND == EK_MRG) {
#pragma unroll
                    for (int bj = 0; bj < 2; ++bj) { const int col = u.pn * 256 + bj * 128 + c8t;
                        f32x4 s0, s1; unpack8(*(const u32x4*)(WSP(const bf16_t, WS_SB) + (size_t)row * DM + col), s0, s1);
                        *(u32x4*)(WSP(bf16_t, WS_MRG) + (size_t)row * DM + col) = pack8(s0 * acc[ai][bj][m][0], s1 * acc[ai][bj][m][1]); }
                } else if constexpr (KIND == EK_PP) {
#pragma unroll
                    for (int bj = 0; bj < 2; ++bj) { const int col = u.pn * 256 + bj * 128 + c8t;
                        *(u32x4*)(WSP(bf16_t, WS_PP) + (size_t)row * DM + col) = pack8(acc[ai][bj][m][0], acc[ai][bj][m][1]); }
                }
            }
    }
};


template <int KIND, int LDA, int LDB, int KK>
__device__ __forceinline__ void mini_gemm(Frame& F, const bf16_t* A, const bf16_t* Bt, int mu, const EpiArgs& a) {
    const int lane = F.lane, w = F.wave;
    const int r0 = MP + 64 * (mu >> 4), c0 = 64 * (mu & 15);
    f32x4 acc[4][4];
#pragma unroll
    for (int m = 0; m < 4; ++m)
#pragma unroll
        for (int n = 0; n < 4; ++n) acc[m][n] = (f32x4){0.f, 0.f, 0.f, 0.f};
    int kbeg, ksteps;
    if constexpr (KIND == EK_MRG) { if (w < 4) { kbeg = w * 128; ksteps = 4; } else { kbeg = DSSM + (w - 4) * 64; ksteps = 2; } }
    else { kbeg = w * (KK / 8); ksteps = KK / 8 / 32; }
    const bf16_t* ap = A + (size_t)(r0 + (lane & 15)) * LDA + kbeg + 8 * (lane >> 4);
    const bf16_t* bp = Bt + (size_t)(c0 + (lane & 15)) * LDB + kbeg + 8 * (lane >> 4);
#pragma unroll 2
    for (int s = 0; s < ksteps; ++s) {
        bf16x8 af[4], bfr[4];
#pragma unroll
        for (int m = 0; m < 4; ++m) af[m] = *(const bf16x8*)(ap + (size_t)16 * m * LDA + 32 * s);
#pragma unroll
        for (int n = 0; n < 4; ++n) bfr[n] = *(const bf16x8*)(bp + (size_t)16 * n * LDB + 32 * s);
#pragma unroll
        for (int m = 0; m < 4; ++m)
#pragma unroll
            for (int n = 0; n < 4; ++n) acc[m][n] = __builtin_amdgcn_mfma_f32_16x16x32_bf16(bfr[n], af[m], acc[m][n], 0, 0, 0);
    }
    __syncthreads();
    LAS float* P = (LAS float*)F.lds;
#pragma unroll
    for (int m = 0; m < 4; ++m)
#pragma unroll
        for (int n = 0; n < 4; ++n) { const int row = 16 * m + (lane & 15), chunk = 4 * n + (lane >> 4); *(LAS f32x4*)(P + w * 4096 + row * 64 + ((chunk ^ (row & 15)) << 2)) = acc[m][n]; }
    __syncthreads();
    const int row = F.tid >> 3, ch = 2 * (F.tid & 7);
    f32x4 x0 = {0.f, 0.f, 0.f, 0.f}, x1 = x0, y0 = x0, y1 = x0;
#pragma unroll
    for (int w2 = 0; w2 < 8; ++w2) { const f32x4 p0 = *(const LAS f32x4*)(P + w2 * 4096 + row * 64 + ((ch ^ (row & 15)) << 2)), p1 = *(const LAS f32x4*)(P + w2 * 4096 + row * 64 + (((ch + 1) ^ (row & 15)) << 2));
        if (KIND == EK_MRG && w2 >= 4) { y0 += p0; y1 += p1; } else { x0 += p0; x1 += p1; } }
    const int grow = r0 + row, gcol = c0 + 8 * (F.tid & 7);
    if constexpr (KIND == EK_MRG) {
        f32x4 a0, a1, b0, b1; unpack8(*(const u32x4*)(WSP(const bf16_t, WS_SA) + (size_t)grow * DM + gcol), a0, a1); unpack8(*(const u32x4*)(WSP(const bf16_t, WS_SB) + (size_t)grow * DM + gcol), b0, b1);
        *(u32x4*)(WSP(bf16_t, WS_MRG) + (size_t)grow * DM + gcol) = pack8(a0 * x0 + b0 * y0, a1 * x1 + b1 * y1);
    } else {
        float sq = resid8<KIND>(a, grow, gcol, x0, x1);
        sq += __shfl_xor(sq, 1); sq += __shfl_xor(sq, 2); sq += __shfl_xor(sq, 4);
        if ((F.tid & 7) == 0) atomicAdd(WSP(float, WS_SSQ) + (size_t)a.ssq_o * M + grow, sq);
    }
    __syncthreads();
}

#define DEFCFG(NAME, KIND_, LDA_, LDB_, KK_, NM_, NN_, NGRP_, GSA_, GSB_) struct NAME { static constexpr int KIND = KIND_, LDA = LDA_, LDB = LDB_, KK = KK_, NM = NM_, NN = NN_, NGRP = NGRP_, UPC = 0, MIDT = 0; static constexpr long GSA = GSA_, GSB = GSB_; }
DEFCFG(CfgGU,   EK_SWIGLU, DM,   DM,   DM,   M / 256, 22, 1, 0, 0);
DEFCFG(CfgPP,   EK_PP,     DPLE, DPLE, DPLE, M / 256, 4,  1, 0, 0);
DEFCFG(CfgDown, EK_RESID,  DFF,  DFF,  DFF,  MP / 256, 4, 1, 0, 0);
DEFCFG(CfgWin,  EK_WIN,    DM,   DM,   DM,   M / 256, 19, 1, 0, 0);
DEFCFG(CfgS1,   EK_S1,     UGP,  512,  512,  2, 1, NG, (long)NCR * UGP, 256L * 512);
DEFCFG(CfgSS,   EK_SS,     256,  256,  256,  1, 1, NG, 128L * 256, 256L * 256);
struct CfgS2 { static constexpr int KIND = EK_S2, LDA = UGP, LDB = UGP, KK = UGP, NM = 2, NN = 2, NGRP = NG, UPC = 2, MIDT = 0; static constexpr long GSA = (long)NCR * UGP, GSB = 512L * UGP; };
DEFCFG(CfgGLU,  EK_GLU,    DSSM, DSSM, DSSM, M / 256, 2,  1, 0, 0);
struct CfgMrg { static constexpr int KIND = EK_MRG, LDA = KMRG, LDB = KMRG, KK = KMRG, NM = MP / 256, NN = 4, NGRP = 1, UPC = 0, MIDT = 8; static constexpr long GSA = 0, GSB = 0; };
DEFCFG(CfgOut,  EK_RESID,  DM,   DM,   DM,   MP / 256, 4, 1, 0, 0);
DEFCFG(CfgPle,  EK_PLE,    DM,   DM,   DM,   MP / 256, 4, 1, 0, 0);

typedef GAS unsigned gu32;
#define RLX_AGENT __ATOMIC_RELAXED, __HIP_MEMORY_SCOPE_AGENT
#define XB_TMO      128
#define XB_XCNT(j)  (256  + 64 * (j))
#define XB_XSUB(j)  (1280 + 64 * (j))
#define XB_XGEN(j)  (2304 + 64 * (j))
#define XB_TOP      3328
#define XB_TOPGEN   3392
#define XCD_BAR_WORDS 3456
#define XB_SPIN_CAP (1u << 18)
__device__ __forceinline__ unsigned xb_ld(unsigned* p)              { return __hip_atomic_load(p, __ATOMIC_RELAXED, __HIP_MEMORY_SCOPE_AGENT); }
__device__ __forceinline__ unsigned xb_add(unsigned* p, unsigned v) { return __hip_atomic_fetch_add(p, v, __ATOMIC_RELAXED, __HIP_MEMORY_SCOPE_AGENT); }
__device__ __forceinline__ unsigned xb_xcc_id() { return (unsigned)__builtin_amdgcn_s_getreg((3 << 11) | 20) & 0xFu; }
#define XB_SPIN(cond, bar) do { unsigned _sp = 0; while (cond) { __builtin_amdgcn_s_sleep(1); \
    if ((++_sp & 255u) == 0u) { if (xb_ld(&(bar)[XB_TMO])) break; if (_sp > XB_SPIN_CAP) { atomicAdd(&(bar)[XB_TMO], 1u); break; } } } } while (0)
struct XcdBarrier { unsigned* bar; unsigned x; volatile LAS unsigned* st; };
__device__ __forceinline__ XcdBarrier xcd_barrier_post(unsigned* bar, volatile LAS unsigned* st) {
    XcdBarrier b; b.bar = bar; b.x = xb_xcc_id(); b.st = st;
    if (threadIdx.x == 0) (void)xb_add(&bar[XB_XCNT(b.x)], 1u);
    return b;
}
__device__ __forceinline__ void xcd_barrier_complete(unsigned* bar, unsigned x, unsigned& nloc, unsigned& nx) {
    const unsigned G = gridDim.x * gridDim.y * gridDim.z;
    unsigned sum, cnt, mine, sp = 0u;
    for (;;) {
        sum = 0u; cnt = 0u; mine = 0u;
#pragma unroll
        for (unsigned j = 0; j < 16; ++j) { const unsigned c = xb_ld(&bar[XB_XCNT(j)]); sum += c; cnt += (c > 0u) ? 1u : 0u; mine = (j == x) ? c : mine; }
        if (sum == G) break;
        __builtin_amdgcn_s_sleep(1);
        if ((++sp & 255u) == 0u) { if (xb_ld(&bar[XB_TMO])) break; if (sp > XB_SPIN_CAP) { atomicAdd(&bar[XB_TMO], 1u); break; } }
    }
    nloc = mine > 0u ? mine : 1u; nx = cnt > 0u ? cnt : 1u;
}
__device__ __forceinline__ void xcd_barrier(const XcdBarrier& b) {
    asm volatile("s_waitcnt vmcnt(0)" ::: "memory");
    __syncthreads();
    if (threadIdx.x == 0) {
        unsigned* bar = b.bar;
        __builtin_amdgcn_s_waitcnt(0);
        unsigned nloc = b.st[0], nx = b.st[1];
        if (nloc == 0u) { xcd_barrier_complete(bar, b.x, nloc, nx); b.st[0] = nloc; b.st[1] = nx; }
        const unsigned old = xb_add(&bar[XB_XSUB(b.x)], 1u);
        const unsigned gen = old / nloc;
        if (old + 1u == (gen + 1u) * nloc) {
            __builtin_amdgcn_fence(__ATOMIC_RELEASE, "agent");
            asm volatile("s_waitcnt vmcnt(0)" ::: "memory");
            const unsigned og = xb_add(&bar[XB_TOP], 1u);
            const unsigned tg = og / nx;
            if (og + 1u == (tg + 1u) * nx) xb_add(&bar[XB_TOPGEN], 1u);
            else XB_SPIN(xb_ld(&bar[XB_TOPGEN]) == tg, bar);
            __builtin_amdgcn_fence(__ATOMIC_ACQUIRE, "agent");
            xb_add(&bar[XB_XGEN(b.x)], 1u);
            asm volatile("s_waitcnt vmcnt(0)" ::: "memory");
        } else {
            XB_SPIN(xb_ld(&bar[XB_XGEN(b.x)]) == gen, bar);
            __builtin_amdgcn_fence(__ATOMIC_ACQUIRE, "agent");
            asm volatile("s_waitcnt vmcnt(0)" ::: "memory");
        }
    }
    __syncthreads();
}

__device__ __forceinline__ void p0_transpose_item(const float* W, int N, bf16_t* WT, int ldt, int k0, int n0, int dst_row0, const float* gk, LAS float* scr, int lane) {
    f32x4 v[16];
#pragma unroll
    for (int i = 0; i < 16; ++i) { const int kk = 4 * i + (lane >> 4); v[i] = *(const f32x4*)(W + (size_t)(k0 + kk) * N + n0 + 4 * (lane & 15)); }
    if (gk) {
#pragma unroll
        for (int i = 0; i < 16; ++i) v[i] = v[i] * gk[k0 + 4 * i + (lane >> 4)]; }
#pragma unroll
    for (int i = 0; i < 16; ++i) { const int kk = 4 * i + (lane >> 4); *(LAS f32x4*)(scr + kk * 64 + ((4 * (lane & 15)) ^ (((kk >> 3) & 7) << 2))) = v[i]; }
    LDS_WAIT(); asm volatile("" ::: "memory");
    const int c = lane & 7;
#pragma unroll
    for (int j = 0; j < 8; ++j) { const int n = (lane >> 3) + 8 * j; const LAS float* s = scr + (8 * c) * 64 + (n ^ (c << 2));
        u32x4 o; o.x = cvtpk(s[0 * 64], s[1 * 64]); o.y = cvtpk(s[2 * 64], s[3 * 64]); o.z = cvtpk(s[4 * 64], s[5 * 64]); o.w = cvtpk(s[6 * 64], s[7 * 64]);
        *(u32x4*)(WT + (size_t)(dst_row0 + n) * ldt + k0 + 8 * c) = o; }
    LDS_WAIT(); asm volatile("" ::: "memory");
}
struct WJob { const float* W; int K, N; bf16_t* WT; const float* gk; int mode; int ldt, koff; };
__device__ __forceinline__ void p0_wjob(const WJob& j, int item, LAS float* scr, int lane) {
    const int nblk = j.N / 64, kb = item / nblk, nb = item % nblk, n0 = 64 * nb;
    const int dst = j.mode == 0 ? n0 : (n0 / 128) * 256 + (n0 % 128) + (j.mode == 2 ? 128 : 0);
    p0_transpose_item(j.W, j.N, j.WT + j.koff, j.ldt, 64 * kb, n0, dst, j.gk, scr, lane);
}

__device__ __forceinline__ double dexp(double x) {
    const double k = __builtin_rint(x * 1.4426950408889634074), r = __builtin_fma(-k, 6.93147180369123816490e-01, x) - k * 1.90821492927058770002e-10;
    double p = 1.0 / 479001600.0;
    p = p * r + 1.0 / 39916800.0; p = p * r + 1.0 / 3628800.0; p = p * r + 1.0 / 362880.0; p = p * r + 1.0 / 40320.0; p = p * r + 1.0 / 5040.0; p = p * r + 1.0 / 720.0;
    p = p * r + 1.0 / 120.0; p = p * r + 1.0 / 24.0; p = p * r + 1.0 / 6.0; p = p * r + 0.5; p = p * r + 1.0; p = p * r + 1.0;
    return __builtin_ldexp(p, (int)k);
}
__device__ __forceinline__ void dsincos(double a, double& s, double& c) {
    const double k = __builtin_rint(a * 0.63661977236758134308);
    double r = __builtin_fma(-k, 1.57079632673412561417e+00, a); r = __builtin_fma(-k, 6.07710050650619224932e-11, r);
    const double z = r * r;
    double sp = -1.0 / 1307674368000.0; sp = sp * z + 1.0 / 6227020800.0; sp = sp * z - 1.0 / 39916800.0; sp = sp * z + 1.0 / 362880.0; sp = sp * z - 1.0 / 5040.0; sp = sp * z + 1.0 / 120.0; sp = sp * z - 1.0 / 6.0; sp = sp * z * r + r;
    double cp = 1.0 / 20922789888000.0; cp = cp * z - 1.0 / 87178291200.0; cp = cp * z + 1.0 / 479001600.0; cp = cp * z - 1.0 / 3628800.0; cp = cp * z + 1.0 / 40320.0; cp = cp * z - 1.0 / 720.0; cp = cp * z + 1.0 / 24.0; cp = cp * z - 0.5; cp = cp * z + 1.0;
    const int q = ((int)k) & 3;
    s = (q == 0) ? sp : (q == 1) ? cp : (q == 2) ? -sp : -cp;
    c = (q == 0) ? cp : (q == 1) ? -sp : (q == 2) ? -cp : sp;
}
__device__ __forceinline__ void cpow_d(double are, double aim, double dt, int n, double& pr, double& pi) {
    const double mag = dexp((double)n * are * dt); double s, c; dsincos((double)n * aim * dt, s, c); pr = mag * c; pi = mag * s;
}
__device__ __forceinline__ void ffac_d(double are, double aim, double dt, double& fr, double& fi) {
    double er, ei; cpow_d(are, aim, dt, 1, er, ei);
    const double nr = er - 1.0, ni = ei, den = are * are + aim * aim;
    fr = (nr * are + ni * aim) / den; fi = (ni * are - nr * aim) / den;
}

__device__ __forceinline__ void phase_prologue(Frame& F) {
    KArgs ka = kargs(); const __attribute__((address_space(4))) cfp_t* in = ka->in; unsigned char* ws = ka->ws;
    LAS float* scr = (LAS float*)(F.lds + F.wave * 16384);
    int it = F.gw;
#define DOJOB(W_, K_, N_, WT_, GK_, MODE_) DOJOB2(W_, K_, N_, WT_, GK_, MODE_, K_, 0)
#define DOJOB2(W_, K_, N_, WT_, GK_, MODE_, LDT_, KOFF_) do { const WJob jb{W_, K_, N_, (bf16_t*)(ws + WT_), GK_, MODE_, LDT_, KOFF_}; const int n_items = ((K_) / 64) * ((N_) / 64); \
        for (; it < n_items; it += F.NGW) p0_wjob(jb, it, scr, F.lane); it -= n_items; } while (0)
    DOJOB(in[9], DM, DFF, WS_W1GU, in[8], 1); DOJOB(in[10], DM, DFF, WS_W1GU, in[8], 2); DOJOB(in[11], DFF, DM, WS_W1D, nullptr, 0);
    DOJOB(in[13], DM, DIN, WS_WIN, in[12], 0); DOJOB(in[22], DSSM, DSSM, WS_WGLU, nullptr, 0); DOJOB2(in[23], DSSM, DM, WS_WBS, nullptr, 0, KMRG, 0);
    DOJOB2(in[24], 256, DM, WS_WBS, nullptr, 0, KMRG, DSSM); DOJOB(in[25], DM, DM, WS_WOUT, nullptr, 0);
    DOJOB(in[27], DM, DFF, WS_W2GU, in[26], 1); DOJOB(in[28], DM, DFF, WS_W2GU, in[26], 2); DOJOB(in[29], DFF, DM, WS_W2D, nullptr, 0);
    DOJOB(in[31], DM, DM, WS_WPG, in[30], 0); DOJOB(in[32], DPLE, DM, WS_WPP, nullptr, 0);
#undef DOJOB
#undef DOJOB2
    float* ssq0 = (float*)(ws + WS_SSQ);
    bf16_t* XB = (bf16_t*)(ws + WS_XB); bf16_t* PB = (bf16_t*)(ws + WS_PB);
    for (int m = F.gw; m < M; m += F.NGW) {
        const float* xr = m < MP ? in[0] + (size_t)m * DM : in[1] + (size_t)(m - MP) * DM;
        f32x4 v[4]; float s = 0.f;
#pragma unroll
        for (int j = 0; j < 4; ++j) { v[j] = ((const f32x4*)xr)[F.lane + 64 * j]; s += (v[j][0] * v[j][0] + v[j][1] * v[j][1]) + (v[j][2] * v[j][2] + v[j][3] * v[j][3]); }
        s = wave_sum(s);
        if (F.lane == 0) ssq0[m] = s;
#pragma unroll
        for (int j = 0; j < 4; ++j) { u32x2 w; w.x = cvtpk(v[j][0], v[j][1]); w.y = cvtpk(v[j][2], v[j][3]); ((u32x2*)(XB + (size_t)m * DM))[F.lane + 64 * j] = w; }
        const float* pr = m < MP ? in[2] + (size_t)m * DPLE : in[3] + (size_t)(m - MP) * DPLE;
        const f32x4 pv = ((const f32x4*)pr)[F.lane]; u32x2 w; w.x = cvtpk(pv[0], pv[1]); w.y = cvtpk(pv[2], pv[3]); ((u32x2*)(PB + (size_t)m * DPLE))[F.lane] = w;
    }
    bf16_t* USX = (bf16_t*)(ws + WS_USX);
    for (int i = F.gw; i < NSB * NG; i += F.NGW) { const int n = i / NG, g = i % NG;
        if (F.lane < 32) { const f32x4 v = ((const f32x4*)(in[7] + ((size_t)n * NG + g) * 128))[F.lane]; u32x2 w; w.x = cvtpk(v[0], v[1]); w.y = cvtpk(v[2], v[3]);
            ((u32x2*)(USX + ((size_t)g * 128 + n) * 256))[F.lane] = w; } }
    float* POW = (float*)(ws + WS_POW); float* BBAR = (float*)(ws + WS_BBAR);
    const int gt = F.gw * 64 + F.lane, NT = F.NGW * 64;
    for (int i = gt; i < NG * NP * 33 + NG * NP; i += NT) {
        if (i < NG * NP * 33) { const int gp = i / 33, n = i % 33, g = gp / NP;
            const double are = in[14][gp], aim = in[15][gp], dt = dexp((double)in[16][g]); double pr, pi; cpow_d(are, aim, dt, n, pr, pi);
            POW[(size_t)i * 2] = (float)pr; POW[(size_t)i * 2 + 1] = (float)pi;
        } else { const int gp = i - NG * NP * 33, g = gp / NP;
            const double are = in[14][gp], aim = in[15][gp], dt = dexp((double)in[16][g]); double fr, fi; ffac_d(are, aim, dt, fr, fi);
#pragma unroll 4
            for (int c = 0; c < 16; ++c) { const double br = in[17][gp * 16 + c], bi = in[18][gp * 16 + c];
                BBAR[((size_t)gp * 16 + c) * 2] = (float)(fr * br - fi * bi); BBAR[((size_t)gp * 16 + c) * 2 + 1] = (float)(fr * bi + fi * br); }
        }
    }
}

__device__ __forceinline__ void phase_build_ssm(Frame& F, int part) {
    KArgs ka = kargs(); const __attribute__((address_space(4))) cfp_t* in = ka->in; unsigned char* ws = ka->ws;
    const float* POW = (const float*)(ws + WS_POW); const float* BBAR = (const float*)(ws + WS_BBAR); float* KTAB = (float*)(ws + WS_KTAB);
    bf16_t* WM = (bf16_t*)(ws + WS_WM); bf16_t* B2 = (bf16_t*)(ws + WS_B2); bf16_t* BS = (bf16_t*)(ws + WS_BS);
    const int gt = F.gw * 64 + F.lane, NT = F.NGW * 64;
    if (part == 1) {
        for (int i = gt; i < NG * TCH * 256; i += NT) {
            const int g = i / (TCH * 256), tau = (i / 256) % TCH, c = (i >> 4) & 15, c2 = i & 15; float s = 0.f;
#pragma unroll 8
            for (int p = 0; p < NP; ++p) { const f32x2 pw = *(const f32x2*)(POW + ((size_t)(g * NP + p) * 33 + tau) * 2), bb = *(const f32x2*)(BBAR + ((size_t)(g * NP + p) * 16 + c2) * 2);
                const float zr = pw.x * bb.x - pw.y * bb.y, zi = pw.x * bb.y + pw.y * bb.x; s += in[19][(g * 16 + c) * NP + p] * zr - in[20][(g * 16 + c) * NP + p] * zi; }
            KTAB[i] = s;
        }
        constexpr int N_WM = NG * 256 * 64, N_B2 = NG * 512 * 16, N_BS = NG * 128 * 16 + NG * 128 * 32;
        for (int i = gt; i < N_WM + N_B2 + N_BS; i += NT) {
            float v[8]; bf16_t* dst;
            if (i < N_WM) {
                const int g = i / (256 * 64), r = i % (256 * 64), n = r / 64, k8 = (r % 64) * 8; dst = WM + ((size_t)g * 256 + n) * 512 + k8;
                if (n < 128) { const int p = n >> 1, ri = n & 1, s = k8 >> 4, c0 = k8 & 15; const float pr = POW[((size_t)(g * NP + p) * 33 + (31 - s)) * 2], pi = POW[((size_t)(g * NP + p) * 33 + (31 - s)) * 2 + 1];
#pragma unroll
                    for (int j = 0; j < 8; ++j) { const float br = BBAR[((size_t)(g * NP + p) * 16 + c0 + j) * 2], bi = BBAR[((size_t)(g * NP + p) * 16 + c0 + j) * 2 + 1]; v[j] = ri ? pr * bi + pi * br : pr * br - pi * bi; } }
                else {
#pragma unroll
                    for (int j = 0; j < 8; ++j) v[j] = 0.f; }
            } else {
                int g, t, c, k8; bool carry;
                const int i2 = i - N_WM;
                if (i2 < N_B2) { g = i2 / (512 * 16); const int r = i2 % (512 * 16), row = r / 16; k8 = (r % 16) * 8; t = row >> 4; c = row & 15; dst = B2 + ((size_t)g * 512 + row) * UGP + k8; carry = true; }
                else { const int i3 = i2 - N_B2;
                    if (i3 < NG * 128 * 16) { g = i3 / (128 * 16); const int r = i3 % (128 * 16), row = r / 16; k8 = (r % 16) * 8; t = row >> 4; c = row & 15; dst = BS + ((size_t)g * 256 + row) * 256 + k8; carry = true; }
                    else { const int i4 = i3 - NG * 128 * 16; g = i4 / (128 * 32); const int r = i4 % (128 * 32), row = 128 + r / 32; k8 = (r % 32) * 8; t = row; c = 0; dst = BS + ((size_t)g * 256 + row) * 256 + k8; carry = false; } }
                if (carry) {
#pragma unroll
                    for (int jj = 0; jj < 4; ++jj) { const int p = (k8 >> 1) + jj; const float pr = POW[((size_t)(g * NP + p) * 33 + (t + 1)) * 2], pi = POW[((size_t)(g * NP + p) * 33 + (t + 1)) * 2 + 1];
                        const float cr = in[19][(g * 16 + c) * NP + p], ci = in[20][(g * 16 + c) * NP + p]; v[2 * jj] = cr * pr - ci * pi; v[2 * jj + 1] = -(cr * pi + ci * pr); }
                } else { const int row = t, p = (row - 128) >> 1, ri = row & 1;
                    if (k8 < 128) { const float ar = POW[((size_t)(g * NP + p) * 33 + 8) * 2], ai = POW[((size_t)(g * NP + p) * 33 + 8) * 2 + 1];
#pragma unroll
                        for (int j = 0; j < 8; ++j) { const int p2 = (k8 + j) >> 1, ri2 = (k8 + j) & 1; v[j] = p2 != p ? 0.f : (ri == 0 ? (ri2 == 0 ? ar : -ai) : (ri2 == 0 ? ai : ar)); }
                    } else { const int s = (k8 - 128) >> 4, c0 = (k8 - 128) & 15; const float pr = POW[((size_t)(g * NP + p) * 33 + (7 - s)) * 2], pi = POW[((size_t)(g * NP + p) * 33 + (7 - s)) * 2 + 1];
#pragma unroll
                        for (int j = 0; j < 8; ++j) { const float br = BBAR[((size_t)(g * NP + p) * 16 + c0 + j) * 2], bi = BBAR[((size_t)(g * NP + p) * 16 + c0 + j) * 2 + 1]; v[j] = ri ? pr * bi + pi * br : pr * br - pi * bi; } }
                }
            }
            u32x4 w; w.x = cvtpk(v[0], v[1]); w.y = cvtpk(v[2], v[3]); w.z = cvtpk(v[4], v[5]); w.w = cvtpk(v[6], v[7]);
            *(u32x4*)dst = w;
        }
    } else {
        constexpr int N_B2 = NG * 512 * 64, N_BS = NG * 128 * 16;
        for (int i = gt; i < N_B2 + N_BS; i += NT) {
            int g, t, c, k8; bf16_t* dst;
            if (i < N_B2) { g = i / (512 * 64); const int r = i % (512 * 64), row = r / 64; k8 = (r % 64) * 8; t = row >> 4; c = row & 15; dst = B2 + ((size_t)g * 512 + row) * UGP + 128 + k8; }
            else { const int i2 = i - N_B2; g = i2 / (128 * 16); const int r = i2 % (128 * 16), row = r / 16; k8 = (r % 16) * 8; t = row >> 4; c = row & 15; dst = BS + ((size_t)g * 256 + row) * 256 + 128 + k8; }
            const int s = k8 >> 4, c0 = k8 & 15;
            u32x4 w = {0u, 0u, 0u, 0u};
            if (s <= t) { const f32x4 a = *(const f32x4*)(KTAB + ((size_t)(g * TCH + (t - s)) * 16 + c) * 16 + c0), b = *(const f32x4*)(KTAB + ((size_t)(g * TCH + (t - s)) * 16 + c) * 16 + c0 + 4); w = pack8(a, b); }
            *(u32x4*)dst = w;
        }
    }
}

constexpr int VROWB = 144, KIMG_OFF = 0, VIMG_OFF = 384 * 128, XSLOT_OFF = 8 * 16384 - 12288;
__device__ __forceinline__ s16x4 vtr(LAS const unsigned char* p) { return __builtin_bit_cast(s16x4, __builtin_amdgcn_ds_read_tr16_b64_v4i16((LAS s16x4*)p)); }
__device__ __forceinline__ void attn_prompt_unit(const bf16_t* QB, const bf16_t* KB, const bf16_t* VB, bf16_t* OG, float* LSE, int b, int g, int r, int h, int qb, LAS unsigned char* lds, int tid) {
    const int lane = tid & 63, wave = __builtin_amdgcn_readfirstlane(tid >> 6);
    const int r32 = lane & 31, hi = lane >> 5, d = 1 << (2 * g), P0 = qb * 256, m0 = P0 + 32 * wave;
    const long tok0 = (long)b * SEQ + r;
    const size_t coff = (size_t)g * 256 + h * 64;
    u32x4 kreg[6], vreg[6];
#pragma unroll
    for (int i = 0; i < 6; ++i) { const int idx = tid + 512 * i, row = idx >> 3, ch = idx & 7, pos = P0 - 128 + row;
        if (pos >= 0) { const size_t go = (size_t)(tok0 + (long)d * pos) * 768 + coff + ch * 8; kreg[i] = *(const u32x4*)(KB + go); vreg[i] = *(const u32x4*)(VB + go); }
        else { kreg[i] = (u32x4){0u, 0u, 0u, 0u}; vreg[i] = kreg[i]; } }
    const bf16_t* qrow = QB + (size_t)(tok0 + (long)d * (m0 + r32)) * 768 + coff;
    bf16x8 qf[4];
#pragma unroll
    for (int ks = 0; ks < 4; ++ks) qf[ks] = *(const bf16x8*)(qrow + 16 * ks + 8 * hi);
#pragma unroll
    for (int i = 0; i < 6; ++i) { const int idx = tid + 512 * i, row = idx >> 3, ch = idx & 7;
        *(LAS u32x4*)(lds + KIMG_OFF + row * 128 + ((ch ^ (row & 7)) << 4)) = kreg[i];
        *(LAS u32x4*)(lds + VIMG_OFF + row * VROWB + ch * 16) = vreg[i]; }
    __syncthreads();
    float m_run = -1e30f, l_run = 0.f; f32x16 o0 = {}, o1 = {};
    const int trq = (lane & 15) >> 2, trp = lane & 3, trc = 16 * ((lane >> 4) & 1) + 4 * trp;
#pragma unroll 1
    for (int kt = 4; kt >= 0; --kt) {
        const int kp0 = m0 - 128 + 32 * kt; if (kp0 < 0) continue;
        const int kr0 = 32 * (wave + kt);
        const int krow = kr0 + r32;
        f32x16 s = {};
#pragma unroll
        for (int ks = 0; ks < 4; ++ks) { const bf16x8 kf = *(const LAS bf16x8*)(lds + KIMG_OFF + krow * 128 + (((2 * ks + hi) ^ (krow & 7)) << 4)); s = __builtin_amdgcn_mfma_f32_32x32x16_bf16(kf, qf[ks], s, 0, 0, 0); }
        float mx = -1e30f;
#pragma unroll
        for (int rr = 0; rr < 16; ++rr) { const int kk = (rr & 3) + 8 * (rr >> 2) + 4 * hi;
            if ((kt == 0 && kk < r32) || (kt == 4 && kk > r32)) s[rr] = -1e30f;
            mx = fmaxf(mx, s[rr]); }
        mx = fmaxf(mx, __shfl_xor(mx, 32));
        const float m_new = fmaxf(m_run, mx), alpha = __builtin_amdgcn_exp2f(m_run - m_new);
        float rsum = 0.f;
#pragma unroll
        for (int rr = 0; rr < 16; ++rr) { s[rr] = __builtin_amdgcn_exp2f(s[rr] - m_new); rsum += s[rr]; }
        rsum += __shfl_xor(rsum, 32);
        l_run = l_run * alpha + rsum; m_run = m_new;
#pragma unroll
        for (int rr = 0; rr < 16; ++rr) { o0[rr] *= alpha; o1[rr] *= alpha; }
        bf16x8 pf[2];
#pragma unroll
        for (int s2 = 0; s2 < 2; ++s2) { u32x4 w; w.x = cvtpk(s[8 * s2], s[8 * s2 + 1]); w.y = cvtpk(s[8 * s2 + 2], s[8 * s2 + 3]); w.z = cvtpk(s[8 * s2 + 4], s[8 * s2 + 5]); w.w = cvtpk(s[8 * s2 + 6], s[8 * s2 + 7]); pf[s2] = __builtin_bit_cast(bf16x8, w); }
#pragma unroll
        for (int s2 = 0; s2 < 2; ++s2) {
#pragma unroll
            for (int dt = 0; dt < 2; ++dt) {
                const int kb = kr0 + 16 * s2 + 4 * hi + trq;
                const s16x4 lo = vtr(lds + VIMG_OFF + kb * VROWB + (32 * dt + trc) * 2), hi4 = vtr(lds + VIMG_OFF + (kb + 8) * VROWB + (32 * dt + trc) * 2);
                const bf16x8 vf = (bf16x8){lo[0], lo[1], lo[2], lo[3], hi4[0], hi4[1], hi4[2], hi4[3]};
                if (dt == 0) o0 = __builtin_amdgcn_mfma_f32_32x32x16_bf16(vf, pf[s2], o0, 0, 0, 0); else o1 = __builtin_amdgcn_mfma_f32_32x32x16_bf16(vf, pf[s2], o1, 0, 0, 0);
            }
        }
    }
    const float inv = 1.f / l_run;
    const size_t tok = (size_t)(tok0 + (long)d * (m0 + r32));
    bf16_t* orow = OG + ((size_t)g * M + tok) * 256 + h * 64;
#pragma unroll
    for (int rq = 0; rq < 4; ++rq) {
        u32x2 w0, w1; w0.x = cvtpk(o0[4 * rq] * inv, o0[4 * rq + 1] * inv); w0.y = cvtpk(o0[4 * rq + 2] * inv, o0[4 * rq + 3] * inv);
        w1.x = cvtpk(o1[4 * rq] * inv, o1[4 * rq + 1] * inv); w1.y = cvtpk(o1[4 * rq + 2] * inv, o1[4 * rq + 3] * inv);
        *(u32x2*)(orow + 8 * rq + 4 * hi) = w0; *(u32x2*)(orow + 32 + 8 * rq + 4 * hi) = w1;
    }
    if (hi == 0) LSE[((size_t)g * M + tok) * 4 + h] = m_run + __builtin_amdgcn_logf(l_run);
    __syncthreads();
}

template <int CTRL> __device__ __forceinline__ float dpp_add(float v) { return v + __int_as_float(__builtin_amdgcn_update_dpp(0, __float_as_int(v), CTRL, 0xf, 0xf, true)); }
__device__ __forceinline__ float row16_sum(float v) { v = dpp_add<0xB1>(v); v = dpp_add<0x4E>(v); v = dpp_add<0x141>(v); v = dpp_add<0x140>(v); return v; }
template <int NPARTS>
__device__ __forceinline__ void attn_sample_unit(const bf16_t* QB, const float* cache, const float* knew, bf16_t* OG, float* LSE, int n, int g, int l, int lidx, int part, LAS float* xl, int lane) {
    constexpr int LW = 8 / NPARTS;
    const int d = 1 << (2 * g), wb = 128 << (2 * g), row = MP + n * NSL + l;
    const u32x2 qw = *(const u32x2*)(QB + (size_t)row * 768 + g * 256 + lane * 4);
    const f32x4 q = {bflo(qw.x), bfhi(qw.x), bflo(qw.y), bfhi(qw.y)};
    const float* cb = cache + (size_t)n * wb * 512 + lane * 4;
    const float* nb = knew + (size_t)(n * NSL) * 512 + lane * 4;
    float m_run = -1e30f, l_run = 0.f; f32x4 o = {0.f, 0.f, 0.f, 0.f};
    const int ibeg = NPARTS == 4 ? (part == 0 ? 0 : 1 + 32 * part) : (part ? 65 : 0), iend = NPARTS == 4 ? 33 + 32 * part : (part ? 129 : 65);
#pragma unroll 1
    for (int i0 = ibeg; i0 < iend; i0 += 8) {
        f32x4 kx[8], vx[8]; float sc[8];
#pragma unroll
        for (int j = 0; j < 8; ++j) { const int i = i0 + j; const int ridx = wb + l - d * (i < iend ? i : iend - 1);
            const float* p = ridx >= wb ? nb + (size_t)(ridx - wb) * 512 : cb + (size_t)ridx * 512;
            kx[j] = *(const f32x4*)p; vx[j] = *(const f32x4*)(p + 256); }
        float mx = -1e30f;
#pragma unroll
        for (int j = 0; j < 8; ++j) { float s = (q[0] * kx[j][0] + q[1] * kx[j][1]) + (q[2] * kx[j][2] + q[3] * kx[j][3]); s = row16_sum(s); if (i0 + j >= iend) s = -1e30f; sc[j] = s; mx = fmaxf(mx, s); }
        const float m_new = fmaxf(m_run, mx), alpha = __builtin_amdgcn_exp2f(m_run - m_new);
        l_run *= alpha; o = o * alpha; m_run = m_new;
#pragma unroll
        for (int j = 0; j < 8; ++j) { const float p = __builtin_amdgcn_exp2f(sc[j] - m_new); l_run += p; o += p * vx[j]; }
    }
    if (part) { LAS float* slot = xl + (((part - 1) * LW + lidx) * 64 + lane) * 8; slot[0] = m_run; slot[1] = l_run; *(LAS f32x4*)(slot + 4) = o; }
    __syncthreads();
    if (!part) {
#pragma unroll
        for (int k2 = 0; k2 < NPARTS - 1; ++k2) { const LAS float* slot = xl + ((k2 * LW + lidx) * 64 + lane) * 8;
            const float m2 = slot[0], l2 = slot[1]; const f32x4 o2 = *(const LAS f32x4*)(slot + 4);
            const float mn = fmaxf(m_run, m2), a1 = __builtin_amdgcn_exp2f(m_run - mn), a2 = __builtin_amdgcn_exp2f(m2 - mn);
            l_run = l_run * a1 + l2 * a2; o = o * a1 + o2 * a2; m_run = mn; }
        const float inv = 1.f / l_run;
        u32x2 w; w.x = cvtpk(o[0] * inv, o[1] * inv); w.y = cvtpk(o[2] * inv, o[3] * inv);
        *(u32x2*)(OG + ((size_t)g * M + row) * 256 + lane * 4) = w;
        if ((lane & 15) == 0) LSE[((size_t)g * M + row) * 4 + (lane >> 4)] = m_run + __builtin_amdgcn_logf(l_run);
    }
}

constexpr int N_ATT = 2048, CW_TICK = 8192;
__device__ __forceinline__ void phase_attention(Frame& F) {
    constexpr int h = 0;
    KArgs ka = kargs(); unsigned char* ws = ka->ws;
    const bf16_t* QB = (const bf16_t*)(ws + WS_QB); const bf16_t* KB = (const bf16_t*)(ws + WS_KB); const bf16_t* VB = (const bf16_t*)(ws + WS_VB);
    bf16_t* OG = (bf16_t*)(ws + WS_OG); float* LSE = (float*)(ws + WS_LSE);
    unsigned* ctr = (unsigned*)(ws + WS_CTL) + CW_TICK + 64 * h;
    volatile LAS unsigned* tk = (volatile LAS unsigned*)(F.lds + MISC_OFF + 64);
    LAS float* xl = (LAS float*)(F.lds + XSLOT_OFF);
    if (F.tid == 0) tk[0] = __hip_atomic_fetch_add(ctr, 1u, __ATOMIC_RELAXED, __HIP_MEMORY_SCOPE_AGENT);
    for (;;) {
        __syncthreads();
        const int j = (int)tk[0];
        __syncthreads();
        if (j >= N_ATT) break;
        unsigned nxt_ = 0; if (F.tid == 0) nxt_ = __hip_atomic_fetch_add(ctr, 1u, __ATOMIC_RELAXED, __HIP_MEMORY_SCOPE_AGENT);
        int g = -1, uidx;
        if (j < 1536) { const int blk = j / 3, r = j % 3; uidx = blk; if (r == 0) g = 2; else if (r == 1) g = 1; }
        else { const int j2 = j - 1536, blk = j2 >> 1; if ((j2 & 1) == 0) { g = 0; uidx = blk; } else uidx = 512 + blk; }
        if (g >= 0) {
            const float* cache = g == 0 ? ka->in[4] : g == 1 ? ka->in[5] : ka->in[6]; const float* knew = ka->out + (g == 0 ? O_KVS0 : g == 1 ? O_KVS1 : O_KVS2);
            if (g == 0) { const int id = uidx, n = id >> 1, half = id & 1, lidx = F.wave & 3;
                attn_sample_unit<2>(QB, cache, knew, OG, LSE, n, 0, 4 * half + lidx, lidx, F.wave >> 2, xl, F.lane); }
            else { const int id = uidx, n = id >> 2, lp = id & 3, lidx = F.wave & 1, l = g == 2 ? 2 * lp + lidx : lp + 4 * lidx;
                attn_sample_unit<4>(QB, cache, knew, OG, LSE, n, g, l, lidx, F.wave >> 1, xl, F.lane); }
        } else { const int V = uidx, gp = V >> 8, rem = V & 255, b = rem >> 7, rem2 = rem & 127, hh = rem2 & 3, rem3 = rem2 >> 2, d = 1 << (2 * gp), r = rem3 % d, qb = rem3 / d;
            attn_prompt_unit(QB, KB, VB, OG, LSE, b, gp, r, hh, qb, F.lds, F.tid);
        }
        if (F.tid == 0) tk[0] = nxt_;
    }
}

__device__ __forceinline__ void phase_attn_merge(Frame& F) {
    KArgs ka = kargs(); unsigned char* ws = ka->ws; const bf16_t* OG = (const bf16_t*)(ws + WS_OG); const float* LSE = (const float*)(ws + WS_LSE); bf16_t* YA = (bf16_t*)(ws + WS_YGA) + DSSM;
    unsigned* ctr = (unsigned*)(ws + WS_CTL) + CW_TICK + 64 * 2;
    volatile LAS unsigned* tk = (volatile LAS unsigned*)(F.lds + MISC_OFF + 64);
    for (;;) {
        __syncthreads();
        if (F.tid == 0) tk[0] = __hip_atomic_fetch_add(ctr, 1u, __ATOMIC_RELAXED, __HIP_MEMORY_SCOPE_AGENT);
        __syncthreads();
        const int j = (int)tk[0]; if (j >= M / 64) break;
#pragma unroll 2
        for (int rr = 0; rr < 8; ++rr) { const int row = j * 64 + F.wave * 8 + rr;
            const int h = F.lane >> 4;
            const float l0 = LSE[((size_t)0 * M + row) * 4 + h], l1 = LSE[((size_t)1 * M + row) * 4 + h], l2 = LSE[((size_t)2 * M + row) * 4 + h];
            const float mx = fmaxf(l0, fmaxf(l1, l2)); float w0 = __builtin_amdgcn_exp2f(l0 - mx), w1 = __builtin_amdgcn_exp2f(l1 - mx), w2 = __builtin_amdgcn_exp2f(l2 - mx);
            const float inv = 1.f / (w0 + w1 + w2); w0 *= inv; w1 *= inv; w2 *= inv;
            const u32x2 a = *(const u32x2*)(OG + ((size_t)0 * M + row) * 256 + F.lane * 4), b = *(const u32x2*)(OG + ((size_t)1 * M + row) * 256 + F.lane * 4), c = *(const u32x2*)(OG + ((size_t)2 * M + row) * 256 + F.lane * 4);
            u32x2 w; w.x = cvtpk(w0 * bflo(a.x) + w1 * bflo(b.x) + w2 * bflo(c.x), w0 * bfhi(a.x) + w1 * bfhi(b.x) + w2 * bfhi(c.x));
            w.y = cvtpk(w0 * bflo(a.y) + w1 * bflo(b.y) + w2 * bflo(c.y), w0 * bfhi(a.y) + w1 * bfhi(b.y) + w2 * bfhi(c.y));
            *(u32x2*)(YA + (size_t)row * KMRG + F.lane * 4) = w; }
    }
}

__device__ __forceinline__ void ssm_scan_item(Frame& F, int b, int g) {
    KArgs ka = kargs(); unsigned char* ws = ka->ws; float* outp = ka->out; const float* SC = (const float*)(ws + WS_SC); const float* POW = (const float*)(ws + WS_POW); bf16_t* UGX = (bf16_t*)(ws + WS_UGX);
    const float* src = SC + ((size_t)g * NCR + b * NCH) * 128;
    LAS f32x4* L4 = (LAS f32x4*)F.lds;
    __syncthreads();
    { f32x4 t_[16];
#pragma unroll
      for (int i = 0; i < 16; ++i) t_[i] = ((const f32x4*)src)[F.tid + i * NWAVES * 64];
#pragma unroll
      for (int i = 0; i < 16; ++i) L4[F.tid + i * NWAVES * 64] = t_[i]; }
    __syncthreads();
    if (F.wave == 0) {
        const int p = F.lane; const float ar = POW[((size_t)(g * NP + p) * 33 + 32) * 2], ai = POW[((size_t)(g * NP + p) * 33 + 32) * 2 + 1];
        float hr = 0.f, hi = 0.f; const LAS f32x2* L2 = (const LAS f32x2*)F.lds;
#pragma unroll 8
        for (int c = 0; c < NCH; ++c) {
            *(unsigned*)(UGX + ((size_t)g * NCR + b * NCH + c) * UGP + 2 * p) = cvtpk(hr, hi);
            const f32x2 s = L2[c * 64 + p];
            const float nr = ar * hr - ai * hi + s.x, ni = ar * hi + ai * hr + s.y; hr = nr; hi = ni;
        }
        float* o = outp + O_SSMP + ((size_t)(b * NG + g) * NP + p) * 2; o[0] = hr; o[1] = hi;
    }
    VM_WAIT(); __syncthreads();
    __builtin_amdgcn_fence(__ATOMIC_ACQUIRE, "agent"); VM_WAIT();
    __syncthreads();
}

__device__ __forceinline__ void phase_final_norm(Frame& F) {
    KArgs ka = kargs(); const float* ssq4 = (const float*)(ka->ws + WS_SSQ) + 4 * (size_t)M; const float* gf = ka->in[33]; float* outp = ka->out;
    f32x4 gv[4];
#pragma unroll
    for (int j = 0; j < 4; ++j) gv[j] = ((const f32x4*)gf)[F.lane + 64 * j];
    for (int m = F.gw; m < M; m += F.NGW) {
        const float rs = rs_of(ssq4[m]); f32x4* xr = (f32x4*)(outp + (size_t)m * DM);
#pragma unroll
        for (int j = 0; j < 4; ++j) { f32x4 v = xr[F.lane + 64 * j]; xr[F.lane + 64 * j] = v * rs * gv[j]; }
    }
}

constexpr int N_PHASES = 11;
__global__ void __launch_bounds__(NWAVES * 64, 2) mk_fwd(Args args) {
    extern __shared__ __attribute__((aligned(16))) unsigned char lds_raw[];
    Frame F;
    F.lds = (LAS unsigned char*)lds_raw; F.tid = threadIdx.x; F.lane = F.tid & 63; F.wave = __builtin_amdgcn_readfirstlane(F.tid >> 6);
    F.G = gridDim.x; F.gw = blockIdx.x * NWAVES + F.wave; F.NGW = F.G * NWAVES;
    KArgs ka0 = kargs();
    unsigned char* ws = ka0->ws;
    volatile LAS unsigned* MISC = (volatile LAS unsigned*)(F.lds + MISC_OFF);
    for (int u = F.tid; u < (LDS_BYTES - LDSCTL_OFF) / 4; u += NWAVES * 64) ((LAS unsigned*)(F.lds + LDSCTL_OFF))[u] = 0u;
    __syncthreads();
    XcdBarrier bar; bar.bar = (unsigned*)(ws + WS_CTL) + CW_BAR; bar.x = 0; bar.st = nullptr;
    if (MK_N_LAUNCHES == 1) bar = xcd_barrier_post((unsigned*)(ws + WS_CTL) + CW_BAR, MISC + 8);
    const int lo = ka0->ph_lo, hi = ka0->ph_hi;
#ifdef PROBE_T
    if (F.tid == 0) { const unsigned long long t_ = __builtin_amdgcn_s_memrealtime(); MISC[28] = (unsigned)t_; MISC[29] = (unsigned)(t_ >> 32); }
#endif
#define IN(k) (lo <= (k) && (k) < hi)
#ifdef PROBE_T
#define SEAM(k) do { if (IN(k) && IN((k) + 1)) xcd_barrier(bar); if (F.tid == 0) { const unsigned long long t_ = __builtin_amdgcn_s_memrealtime(); MISC[32 + 2 * (k)] = (unsigned)t_; MISC[33 + 2 * (k)] = (unsigned)(t_ >> 32); } } while (0)
#else
#define SEAM(k) do { if (IN(k) && IN((k) + 1)) xcd_barrier(bar); } while (0)
#endif
    LAS unsigned char* ring = F.lds;
    const int cid = (int)blockIdx.x;
#define WSB(off) ((const bf16_t*)(ka->ws + (off)))
#define RUN(CFG, Aoff, Boff, C0, EA) do { Epi<CFG::KIND> E_{EA}; pg8::gemm_phase<CFG>(ring, Aoff, Boff, F.G, cid, C0, E_); } while (0)
#define MINI(CFG, Aoff, Boff, EA) do { for (int mu_ = cid; mu_ < 256; mu_ += F.G) mini_gemm<CFG::KIND, CFG::LDA, CFG::LDB, CFG::KK>(F, Aoff, Boff, mu_, EA); } while (0)
#define EA0() KArgs ka = kargs(); EpiArgs ea{}; ea.ws = ka->ws; ea.out = ka->out; ea.dskip = ka->in[21]

    for (int rep_ = 0; rep_ < 1 + ((PROBE_DUP >> 0) & 1); ++rep_) { if (IN(0)) { phase_prologue(F); } SEAM(0); }
    if (IN(1)) {
        phase_build_ssm(F, 1);
        EA0();
        { EpiArgs e = ea; e.ssq_i = 0; RUN(CfgGU, WSB(WS_XB), WSB(WS_W1GU), 0, e); }
    } SEAM(1);
    if (IN(2)) { phase_build_ssm(F, 2); EA0(); EpiArgs e = ea; e.base0 = ka->in[0]; e.base1 = ka->in[1]; e.ssq_o = 1; e.alpha = 0.5f; RUN(CfgDown, WSB(WS_HID), WSB(WS_W1D), 0, e); MINI(CfgDown, WSB(WS_HID), WSB(WS_W1D), e); } SEAM(2);
    if (IN(3)) { EA0(); EpiArgs e = ea; e.ssq_i = 1; RUN(CfgWin, WSB(WS_XB), WSB(WS_WIN), 0, e);
        constexpr int WIN_LEFT = (M / 256 * 19) % 256;
        if (F.G == 256 && cid >= WIN_LEFT) { Epi<EK_PP> E_{ea}; pg8::gemm_phase<CfgPP>(ring, WSB(WS_PB), WSB(WS_WPP), 256 - WIN_LEFT, cid - WIN_LEFT, 0, E_); }
        else if (F.G != 256) { RUN(CfgPP, WSB(WS_PB), WSB(WS_WPP), 0, ea); } } SEAM(3);
    if (IN(4)) {
        if (cid < NB * NG) { { EA0(); Epi<EK_S1> E_{ea}; pg8::gemm_phase<CfgS1>(ring, WSB(WS_UGX) + 128, WSB(WS_WM), F.G, cid, 0, E_); }
            VM_WAIT(); __syncthreads();
            ssm_scan_item(F, cid & 1, cid >> 1);
            { EA0(); RUN(CfgS2, WSB(WS_UGX), WSB(WS_B2), 0, ea); } }
        else { EA0(); RUN(CfgSS, WSB(WS_USX), WSB(WS_BS), 64, ea); }
        phase_attention(F);
    } SEAM(4);
    if (IN(5)) { { EA0(); RUN(CfgGLU, WSB(WS_YS), WSB(WS_WGLU), 0, ea); } phase_attn_merge(F); } SEAM(5);
    if (IN(6)) { EA0(); RUN(CfgMrg, WSB(WS_YGA), WSB(WS_WBS), 0, ea); MINI(CfgMrg, WSB(WS_YGA), WSB(WS_WBS), ea); } SEAM(6);
    if (IN(7)) { EA0(); EpiArgs e = ea; e.base0 = nullptr; e.base1 = nullptr; e.ssq_o = 2; e.alpha = 1.0f; RUN(CfgOut, WSB(WS_MRG), WSB(WS_WOUT), 0, e); MINI(CfgOut, WSB(WS_MRG), WSB(WS_WOUT), e); } SEAM(7);
    if (IN(8)) { EA0(); EpiArgs e = ea; e.ssq_i = 2; RUN(CfgGU, WSB(WS_XB), WSB(WS_W2GU), 0, e); } SEAM(8);
    if (IN(9)) { EA0(); EpiArgs e = ea; e.base0 = nullptr; e.base1 = nullptr; e.ssq_o = 3; e.alpha = 0.5f; RUN(CfgDown, WSB(WS_HID), WSB(WS_W2D), 0, e); MINI(CfgDown, WSB(WS_HID), WSB(WS_W2D), e); } SEAM(9);
    if (IN(10)) { EA0(); EpiArgs e = ea; e.base0 = nullptr; e.base1 = nullptr; e.ssq_i = 3; e.ssq_o = 4; RUN(CfgPle, WSB(WS_XB), WSB(WS_WPG), 0, e); MINI(CfgPle, WSB(WS_XB), WSB(WS_WPG), e); } SEAM(10);
    if (IN(11)) { phase_final_norm(F); }
#ifdef PROBE_T
    __syncthreads();
    if (blockIdx.x == 0) { KArgs ka = kargs(); const unsigned long long t1 = ((unsigned long long)MISC[33 + 2 * PROBE_T] << 32) | MISC[32 + 2 * PROBE_T];
        unsigned long long t0 = PROBE_T > 0 ? (((unsigned long long)MISC[31 + 2 * PROBE_T] << 32) | MISC[30 + 2 * PROBE_T]) : (((unsigned long long)MISC[29] << 32) | MISC[28]);
        const float us = (float)(long long)(t1 - t0) * 0.01f; float* sp = ka->out + O_SSMP;
        for (int i = F.tid; i < 8192; i += 512) sp[i] *= (1.f + us * 0.001f); }
#endif
#undef IN
#undef SEAM
}

extern "C" void kernel_launch(void* const* d_in, const int* in_sizes, int n_in, void* d_out, int out_size, void* d_ws, size_t ws_size, hipStream_t stream) {
    static int grid = 0;
    if (grid == 0) {
        if (n_in != 34 || out_size != (int)O_END || ws_size < WS_END) { fprintf(stderr, "kernel_launch: unexpected shapes (n_in %d, out %d, ws %zu)\n", n_in, out_size, ws_size); grid = -1; return; }
        int dev = 0, cus = 0, per_cu = 0;
        if (hipGetDevice(&dev) != hipSuccess || hipDeviceGetAttribute(&cus, hipDeviceAttributeMultiprocessorCount, dev) != hipSuccess) { grid = -1; return; }
        if (hipFuncSetAttribute((const void*)mk_fwd, hipFuncAttributeMaxDynamicSharedMemorySize, LDS_BYTES) != hipSuccess) { fprintf(stderr, "kernel_launch: hipFuncSetAttribute failed\n"); grid = -1; return; }
        if (hipOccupancyMaxActiveBlocksPerMultiprocessor(&per_cu, (const void*)mk_fwd, NWAVES * 64, LDS_BYTES) != hipSuccess || per_cu < 1) { fprintf(stderr, "kernel_launch: occupancy query says %d\n", per_cu); }
        (void)hipGetLastError();
        grid = cus;
    }
    if (grid < 0) return;
    (void)hipMemsetAsync((char*)d_ws + WS_CTL, 0, CTL_ZERO_BYTES, stream);
    Args a{};
    for (int i = 0; i < 34; ++i) a.in[i] = (const float*)d_in[i];
    a.out = (float*)d_out; a.ws = (unsigned char*)d_ws;
    if (MK_N_LAUNCHES == 1) { a.ph_lo = 0; a.ph_hi = N_PHASES + 1; hipLaunchKernelGGL(mk_fwd, dim3(grid), dim3(NWAVES * 64), LDS_BYTES, stream, a); }
    else for (int p = 0; p <= N_PHASES; ++p) { a.ph_lo = p; a.ph_hi = p + 1; hipLaunchKernelGGL(mk_fwd, dim3(grid), dim3(NWAVES * 64), LDS_BYTES, stream, a); }
}
```
